# Optimizing an MI355X kernel written in HIP

```python
import jax, jax.numpy as jnp
from jax import lax
import numpy as np

D_MODEL = 2048
BATCH = 16
SEQ = 256
DEPTH = 2
DEC_BATCH = 2
DEC_SEQ = 1024
PAST_LEN = 512

GRID_W = 64
N_MIXERS = 2
N_FOURIER_LAYERS = (DEPTH + 1) // 2
N_GLA_LAYERS = DEPTH // 2
N_MOD = 9
D_FF = 5632
FOURIER_GROUPS = 4
FOURIER_GROUP_W = D_MODEL // FOURIER_GROUPS
GLA_HEADS = 4
DK_TOT = D_MODEL // 2
DV_TOT = D_MODEL
HEAD_K = DK_TOT // GLA_HEADS
HEAD_V = DV_TOT // GLA_HEADS
GATE_RANK = 16
GATE_TAU = 16.0
CHUNK = 64
ROPE_PAIRS = HEAD_K // 4
ROPE_BASE = 10000.0
EPS = 1e-6
GLA_IN_COLS = 4 * DK_TOT + 2 * DV_TOT + 2 * GATE_RANK
GLA_SPLITS = [DK_TOT, 2 * DK_TOT, 3 * DK_TOT, 4 * DK_TOT, 4 * DK_TOT + DV_TOT,
              4 * DK_TOT + 2 * DV_TOT, 4 * DK_TOT + 2 * DV_TOT + GATE_RANK]

kernel_name = 'fourier_gla_macaron_diffusion_step'


def rms_norm(x, g):
    xf = x.astype(jnp.float32)
    y = xf * lax.rsqrt(jnp.mean(xf * xf, axis=-1, keepdims=True) + EPS)
    return (y * g.astype(jnp.float32)).astype(x.dtype)


def modulation(cond, w, b):
    m = jax.nn.silu(cond) @ w + b
    return m.reshape(cond.shape[0], N_MOD, D_MODEL)


def pre_mod(x, g, m, k):
    return rms_norm(x, g) * (1 + m[:, 3 * k + 1, None, :]) + m[:, 3 * k, None, :]


def post_add(x, out, g, m, k, w):
    return x + w * m[:, 3 * k + 2, None, :] * rms_norm(out, g)


def swiglu(h, w_gu, w_down):
    gate, up = jnp.split(h @ w_gu, 2, axis=-1)
    return (jax.nn.silu(gate) * up) @ w_down


def fourier_mix(h, w):
    B, T, _ = h.shape
    hg = h.astype(jnp.float32).reshape(B, T, FOURIER_GROUPS, FOURIER_GROUP_W)
    f = jnp.fft.fft2(hg, axes=(1, 3), norm='ortho').real
    return f.reshape(B, T, D_MODEL).astype(h.dtype) @ w


def axial_rope(rows):
    row = jnp.repeat(jnp.arange(rows), GRID_W).astype(jnp.float32)
    col = jnp.tile(jnp.arange(GRID_W), rows).astype(jnp.float32)
    inv = ROPE_BASE ** (-jnp.arange(ROPE_PAIRS, dtype=jnp.float32) / ROPE_PAIRS)
    ang = jnp.concatenate([row[:, None] * inv, col[:, None] * inv], axis=-1)
    return jnp.cos(ang), jnp.sin(ang)


def apply_rope(x, rope):
    cos, sin = rope
    c = cos[None, :, None, :]
    s = sin[None, :, None, :]
    xr = x.astype(jnp.float32).reshape(x.shape[:-1] + (HEAD_K // 2, 2))
    xe, xo = xr[..., 0], xr[..., 1]
    out = jnp.stack([xe * c - xo * s, xe * s + xo * c], axis=-1)
    return out.reshape(x.shape).astype(x.dtype)


def gla_scan(q, k, v, g, s0):
    B, T, H, _ = q.shape
    n = T // CHUNK

    def chunks(a):
        return a.astype(jnp.float32).reshape(B, n, CHUNK, H, a.shape[-1]).transpose(1, 0, 3, 2, 4)

    causal = jnp.tril(jnp.ones((CHUNK, CHUNK), dtype=bool))[:, :, None]

    def step(S, inp):
        qc, kc, vc, gc = inp
        b = jnp.cumsum(gc, axis=2)
        o_inter = jnp.einsum('bhik,bhkv->bhiv', qc * jnp.exp(b), S)
        diff = b[:, :, :, None, :] - b[:, :, None, :, :]
        decay = jnp.exp(jnp.where(causal, diff, -jnp.inf))
        scores = jnp.einsum('bhik,bhjk,bhijk->bhij', qc, kc, decay)
        o = o_inter + jnp.einsum('bhij,bhjv->bhiv', scores, vc)
        b_last = b[:, :, -1:, :]
        S = jnp.exp(b_last[:, :, 0, :, None]) * S + jnp.einsum(
            'bhjk,bhjv->bhkv', kc * jnp.exp(b_last - b), vc)
        return S, o

    S, o = lax.scan(step, s0.astype(jnp.float32), (chunks(q), chunks(k), chunks(v), chunks(g)))
    o = o.transpose(1, 0, 3, 2, 4).reshape(B, T, H, v.shape[-1])
    return o.astype(v.dtype), S.astype(v.dtype)


def gla_mix(h, w_in, wg_up, b_g, g_norm, w_out, s0, rope):
    B, T, _ = h.shape
    qf, kf, qb, kb, v, r, lr_f, lr_b = jnp.split(h @ w_in, GLA_SPLITS, axis=-1)

    def heads(a):
        return a.reshape(B, T, GLA_HEADS, -1)

    qf, kf, qb, kb, v, r = (heads(a) for a in (qf, kf, qb, kb, v, r))
    if rope is not None:
        qf, kf, qb, kb = (apply_rope(a, rope) for a in (qf, kf, qb, kb))

    def log_decay(lr, d):
        return heads(jax.nn.log_sigmoid((lr @ wg_up[d] + b_g[d]).astype(jnp.float32)) / GATE_TAU)

    scale = HEAD_K ** -0.5
    o_f, s_f = gla_scan(qf * scale, kf, v, log_decay(lr_f, 0), s0[:, 0])

    def flip(a):
        return jnp.flip(a, axis=1)

    o_b, s_b = gla_scan(flip(qb) * scale, flip(kb), flip(v), flip(log_decay(lr_b, 1)), s0[:, 1])
    o = rms_norm(o_f + flip(o_b), g_norm) * jax.nn.silu(r)
    return o.reshape(B, T, DV_TOT) @ w_out, jnp.stack([s_f, s_b], axis=1)


def trunk(x, cond, gla_init, rope, ada_w, ada_b, norm_pre, norm_post, ffn_w_gate_up,
          ffn_w_down, fourier_w, gla_w_in, gla_w_gate_up, gla_b_gate, gla_norm, gla_w_out):
    B = x.shape[0]
    states = []
    for l in range(DEPTH):
        m = modulation(cond, ada_w[l], ada_b[l])
        h = pre_mod(x, norm_pre[l, 0], m, 0)
        x = post_add(x, swiglu(h, ffn_w_gate_up[l, 0], ffn_w_down[l, 0]), norm_post[l, 0], m, 0, 0.5)
        h = pre_mod(x, norm_pre[l, 1], m, 1)
        j = l // N_MIXERS
        if l % N_MIXERS == 0:
            out = fourier_mix(h, fourier_w[j])
        else:
            if gla_init is None:
                s0 = jnp.zeros((B, 2, GLA_HEADS, HEAD_K, HEAD_V), x.dtype)
            else:
                s0 = gla_init[:, j]
            out, st = gla_mix(h, gla_w_in[j], gla_w_gate_up[j], gla_b_gate[j], gla_norm[j],
                              gla_w_out[j], s0, rope)
            states.append(st)
        x = post_add(x, out, norm_post[l, 1], m, 1, 1.0)
        h = pre_mod(x, norm_pre[l, 2], m, 2)
        x = post_add(x, swiglu(h, ffn_w_gate_up[l, 1], ffn_w_down[l, 1]), norm_post[l, 2], m, 2, 0.5)
    return x, states


def setup_inputs(seed: int = 0) -> dict:
    key = jax.random.key(seed)
    ks = jax.random.split(key, 17)
    f32 = jnp.float32
    nrm = lambda k, s, sc: jax.random.normal(k, s, f32) * sc
    return {
        'x_prompt': nrm(ks[0], (BATCH, SEQ, D_MODEL), 1.0),
        'x_sample': nrm(ks[1], (DEC_BATCH, DEC_SEQ, D_MODEL), 1.0),
        'state_gla': nrm(ks[2], (DEC_BATCH, N_GLA_LAYERS, 2, GLA_HEADS, HEAD_K, HEAD_V), 0.5),
        'c': nrm(ks[3], (DEC_BATCH, D_MODEL), 1.0),
        'c_ctx': nrm(ks[4], (D_MODEL,), 1.0),
        'ada_w': nrm(ks[5], (DEPTH, D_MODEL, N_MOD * D_MODEL), 0.5 * D_MODEL ** -0.5),
        'ada_b': nrm(ks[6], (DEPTH, N_MOD * D_MODEL), 0.02),
        'norm_pre': 1.0 + nrm(ks[7], (DEPTH, 3, D_MODEL), 0.02),
        'norm_post': 1.0 + nrm(ks[8], (DEPTH, 3, D_MODEL), 0.02),
        'ffn_w_gate_up': nrm(ks[9], (DEPTH, 2, D_MODEL, 2 * D_FF), D_MODEL ** -0.5),
        'ffn_w_down': nrm(ks[10], (DEPTH, 2, D_FF, D_MODEL), D_FF ** -0.5),
        'fourier_w': nrm(ks[11], (N_FOURIER_LAYERS, D_MODEL, D_MODEL), D_MODEL ** -0.5),
        'gla_w_in': nrm(ks[12], (N_GLA_LAYERS, D_MODEL, GLA_IN_COLS), D_MODEL ** -0.5),
        'gla_w_gate_up': nrm(ks[13], (N_GLA_LAYERS, 2, GATE_RANK, DK_TOT), GATE_RANK ** -0.5),
        'gla_b_gate': nrm(ks[14], (N_GLA_LAYERS, 2, DK_TOT), 0.1),
        'gla_norm': 1.0 + nrm(ks[15], (N_GLA_LAYERS, HEAD_V), 0.02),
        'gla_w_out': nrm(ks[16], (N_GLA_LAYERS, DV_TOT, D_MODEL), DV_TOT ** -0.5),
    }


def reference(x_prompt, x_sample, state_gla, c, c_ctx, ada_w, ada_b, norm_pre, norm_post,
              ffn_w_gate_up, ffn_w_down, fourier_w, gla_w_in, gla_w_gate_up, gla_b_gate,
              gla_norm, gla_w_out):
    y_prompt, ctx_states = trunk(x_prompt, c_ctx[None, :], None, None, ada_w, ada_b, norm_pre,
                                 norm_post, ffn_w_gate_up, ffn_w_down, fourier_w, gla_w_in,
                                 gla_w_gate_up, gla_b_gate, gla_norm, gla_w_out)
    new_state_gla = jnp.stack(ctx_states, axis=1)
    rows = x_sample.shape[1] // GRID_W
    rope = axial_rope(rows)
    y_sample, _ = trunk(x_sample, c, state_gla, rope, ada_w, ada_b, norm_pre, norm_post,
                        ffn_w_gate_up, ffn_w_down, fourier_w, gla_w_in, gla_w_gate_up,
                        gla_b_gate, gla_norm, gla_w_out)
    return (y_prompt, y_sample, new_state_gla)
```

```cpp
#include <hip/hip_runtime.h>
#include <hip/hip_cooperative_groups.h>
#include <cstdio>
#include <cstdint>
namespace cg = cooperative_groups;

#define LAS __attribute__((address_space(3)))
typedef unsigned short bf16_t;
typedef short bf16x8 __attribute__((ext_vector_type(8)));
typedef float f32x4 __attribute__((ext_vector_type(4)));
typedef float f32x2 __attribute__((ext_vector_type(2)));
typedef unsigned u32x4 __attribute__((ext_vector_type(4)));
typedef unsigned u32x2 __attribute__((ext_vector_type(2)));

constexpr int D = 2048, FF = 5632, NCTX = 4096, MROWS = 6144, NMOD = 9 * D;
constexpr int PLD = 6400;
constexpr float EPS = 1e-6f;
constexpr int LDS_BYTES = 157696 + 64, LDS_BARST = 157696;

constexpr size_t MiB = 1u << 20;
constexpr size_t WS_PTRTAB = 32768;
constexpr size_t WS_MOD = 1 * MiB, WS_SQ = 2 * MiB, WS_EL = 3 * MiB, WS_FCT = 4 * MiB, WS_CTC = 5 * MiB, WS_CTL = 6 * MiB;
constexpr size_t WS_LR = 11 * MiB;
constexpr size_t WS_COMB = 12 * MiB;
constexpr size_t WS_W1 = 16 * MiB, WS_W2 = 192 * MiB, WS_FW = 280 * MiB, WS_WO = 288 * MiB, WS_WA = 296 * MiB, WS_WV = 322 * MiB;
constexpr size_t WS_HB = 330 * MiB, WS_HID = 354 * MiB, WS_OUTF = 420 * MiB, WS_P = 468 * MiB, WS_VT = 543 * MiB, WS_QT = 567 * MiB, WS_KT = 591 * MiB;
constexpr size_t WS_KHT = 615 * MiB, WS_O = 639 * MiB, WS_ON = 735 * MiB, WS_YT = 759 * MiB, WS_FB = 807 * MiB, WS_END = 831 * MiB;
constexpr size_t W1_ELEMS = (size_t)11264 * 2048, W2_ELEMS = (size_t)2048 * 5632;

typedef __bf16 bf16x2_t __attribute__((ext_vector_type(2)));
__device__ __forceinline__ unsigned cvt_pk_bf16(float lo, float hi) { const bf16x2_t v = {(__bf16)lo, (__bf16)hi}; return __builtin_bit_cast(unsigned, v); }
__device__ __forceinline__ float bf2f(bf16_t b) { return __uint_as_float(((unsigned)b) << 16); }
__device__ __forceinline__ float wave_sum(float v) {
#pragma unroll
    for (int o = 1; o < 64; o <<= 1) v += __shfl_xor(v, o);
    return v;
}
__device__ __forceinline__ long long ldoff(const long long* tab, int i) {
    const unsigned long long v = (unsigned long long)__hip_atomic_load(tab + i, __ATOMIC_RELAXED, __HIP_MEMORY_SCOPE_AGENT);
    const unsigned lo = __builtin_amdgcn_readfirstlane((unsigned)v), hi = __builtin_amdgcn_readfirstlane((unsigned)(v >> 32));
    return (long long)(((unsigned long long)hi << 32) | lo);
}
__device__ __forceinline__ float silu_f(float g) { return g * __builtin_amdgcn_rcpf(1.0f + __expf(-g)); }

#ifndef GP_SP2
#define GP_SP2 true
#endif
#ifndef GP_ALIGN
#define GP_ALIGN true
#endif
namespace pg8 {
constexpr int BM = 256, BK = 64, HALF = 128, HTB = HALF * BK * 2, NXCD = 8, WGM = 4;
__device__ __forceinline__ int lds_byte(int r, int c) { const int st = (r >> 4) * 2 + (c >> 5), rr = r & 15, cc = c & 31, ob = rr * 64 + cc * 2; return st * 1024 + (ob ^ (((ob >> 9) & 1) << 5)); }
__device__ __forceinline__ void stage_rc(int b, int& R, int& C) { const int st = b / 1024, sb = b % 1024, swz = sb ^ (((sb >> 9) & 1) << 5); R = (st >> 1) * 16 + swz / 64; C = (st & 1) * 32 + (swz % 64) / 2; }
__device__ __forceinline__ int perm32(int rho) { const int n = rho >> 4, i = rho & 15; return 8 * (i >> 2) + 4 * n + (i & 3); }

struct Unit { const char* A; const char* B; int pm, pn, z; };
struct Sched {
    const char* A; const char* B; const char* A2; const char* B2;
    long sAz, sBz;
    int lda, ldb, nM, nN, nZ, nM2, nN2, nwg, G, c, bm;
    __device__ __forceinline__ bool next(int i, Unit& u) const {
        const long L = (long)i * G + c; if (L >= nwg) return false;
        int id = (int)L; { const int q = nwg / NXCD, r = nwg % NXCD, xcd = id % NXCD, off = id / NXCD; id = (xcd < r ? xcd * (q + 1) : r * (q + 1) + (xcd - r) * q) + off; }
        const int slab = nM * nN; int z = id / slab, lid = id - z * slab, tm = nM, tn = nN;
        const char* a = A + (long)z * sAz; const char* b = B + (long)z * sBz;
        if (z >= nZ) { z = nZ; lid = id - nZ * slab; tm = nM2; tn = nN2; a = A2; b = B2; }
        const int nig = WGM * tn, gid = lid / nig, fm = gid * WGM, gsz = (tm - fm) < WGM ? (tm - fm) : WGM;
        u.pm = fm + ((lid % nig) % gsz); u.pn = (lid % nig) / gsz; u.z = z;
        u.A = a + (size_t)u.pm * bm * lda * 2; u.B = b + (size_t)u.pn * BM * ldb * 2;
        return true;
    }
};

struct EpiF32Sq {
    static constexpr bool PERM = true;
    bf16_t* C; float* sq;
    __device__ __forceinline__ void operator()(const f32x4 (&acc)[2][2][3][2], const Unit& u, int wr, int wc, int fr, int fq) const {
        const int row0 = u.pm * 192 + wr * 48 + fr, col0 = u.pn * BM + wc * 32 + 8 * fq;
        const __amdgpu_buffer_rsrc_t rsrc = __builtin_amdgcn_make_buffer_rsrc(C, 0, MROWS * D * 2, 0x00020000);
#pragma unroll
        for (int ai = 0; ai < 2; ++ai)
#pragma unroll
            for (int m = 0; m < 3; ++m) {
                const int row = row0 + ai * 96 + m * 16; const unsigned roff = (unsigned)(row * D + col0) * 2u; float s = 0.f;
#pragma unroll
                for (int bj = 0; bj < 2; ++bj) { const f32x4 v0 = acc[ai][bj][m][0], v1 = acc[ai][bj][m][1];
                    s += (v0[0] * v0[0] + v0[1] * v0[1]) + (v0[2] * v0[2] + v0[3] * v0[3]) + (v1[0] * v1[0] + v1[1] * v1[1]) + (v1[2] * v1[2] + v1[3] * v1[3]);
                    u32x4 w; w.x = cvt_pk_bf16(v0[0], v0[1]); w.y = cvt_pk_bf16(v0[2], v0[3]); w.z = cvt_pk_bf16(v1[0], v1[1]); w.w = cvt_pk_bf16(v1[2], v1[3]);
                    __builtin_amdgcn_raw_buffer_store_b128(w, rsrc, roff + (unsigned)(bj * HALF * 2), 0, 16); }
                s += __shfl_xor(s, 16); s += __shfl_xor(s, 32);
                if (fq == 0) __hip_atomic_store(sq + (size_t)row * 32 + u.pn * 4 + wc, s, __ATOMIC_RELAXED, __HIP_MEMORY_SCOPE_AGENT);
            }
    }
};
template <int MT>
struct EpiSwiGLU {
    static constexpr bool PERM = true;
    bf16_t* H; int row_off, pn_off;
    __device__ __forceinline__ void operator()(const f32x4 (&acc)[2][2][MT][2], const Unit& u, int wr, int wc, int fr, int fq) const {
        const int row0 = u.pm * (64 * MT) + row_off + wr * (16 * MT) + fr, col0 = (u.pn + pn_off) * HALF + wc * 32 + 8 * fq;
        const __amdgpu_buffer_rsrc_t rsrc = __builtin_amdgcn_make_buffer_rsrc(H, 0, MROWS * FF * 2, 0x00020000);
#pragma unroll
        for (int ai = 0; ai < 2; ++ai)
#pragma unroll
            for (int m = 0; m < MT; ++m) {
                const unsigned roff = (unsigned)((row0 + ai * (32 * MT) + m * 16) * FF + col0) * 2u;
                const f32x4 g0 = acc[ai][0][m][0], g1 = acc[ai][0][m][1], u0 = acc[ai][1][m][0], u1 = acc[ai][1][m][1];
                u32x4 w;
                w.x = cvt_pk_bf16(silu_f(g0[0]) * u0[0], silu_f(g0[1]) * u0[1]); w.y = cvt_pk_bf16(silu_f(g0[2]) * u0[2], silu_f(g0[3]) * u0[3]);
                w.z = cvt_pk_bf16(silu_f(g1[0]) * u1[0], silu_f(g1[1]) * u1[1]); w.w = cvt_pk_bf16(silu_f(g1[2]) * u1[2], silu_f(g1[3]) * u1[3]);
                __builtin_amdgcn_raw_buffer_store_b128(w, rsrc, roff, 0, 16);
            }
    }
};
struct EpiLrAtomic {
    static constexpr bool PERM = false;
    float* LR;
    __device__ __forceinline__ void operator()(const f32x4 (&acc)[2][2][4][2], const Unit& u, int wr, int wc, int fr, int fq) const {
        if (wc != 0) return;
        const int row0 = u.pm * BM + wr * 64 + fr;
#pragma unroll
        for (int ai = 0; ai < 2; ++ai)
#pragma unroll
            for (int m = 0; m < 4; ++m) { float* rowp = LR + (size_t)(row0 + ai * HALF + m * 16) * 32 + 4 * fq;
#pragma unroll
                for (int n = 0; n < 2; ++n)
#pragma unroll
                    for (int j = 0; j < 4; ++j) atomicAdd(rowp + n * 16 + j, acc[ai][0][m][n][j]); }
    }
};
enum { M_GIN = 0, M_FA = 1, M_FBC = 2, M_FBL = 3 };
struct EpiBf16 {
    static constexpr bool PERM = true;
    int mode; bf16_t* d0; bf16_t* d1; unsigned char* wsb;
    __device__ __forceinline__ void operator()(const f32x4 (&acc)[2][2][4][2], const Unit& u, int wr, int wc, int fr, int fq) const {
        bf16_t* base; int ldc;
        if (mode == M_GIN) {
            if (u.z == 0) { base = d0 + (size_t)u.pm * BM * PLD + u.pn * BM; ldc = PLD; }
            else if (u.pn < 16) { base = d1 + (size_t)u.pn * (2048 * 256) + (size_t)u.pm * BM * 256; ldc = 256; }
            else { const int b = (u.pn - 16) >> 2, s0 = ((u.pn - 16) & 3) * 256; base = d1 + (size_t)16 * 2048 * 256 + (size_t)b * (2048 * 1024) + (size_t)u.pm * BM * 1024 + s0; ldc = 1024; }
        } else if (mode == M_FA) {
            const int g = u.z, chrow = g * 512 + (u.pm & 1) * 256, part = u.pm >> 1;
            if (u.pn < 16) { base = d0 + (size_t)u.pn * (2048 * 512) + (size_t)chrow * 512 + part * 256; ldc = 512; }
            else { const int b = (u.pn - 16) >> 2, s0 = ((u.pn - 16) & 3) * 256; base = d1 + (size_t)b * (2048 * 2048) + (size_t)chrow * 2048 + part * 1024 + s0; ldc = 2048; }
        } else if (mode == M_FBC) { base = d0 + (size_t)(u.z * 256) * D + u.pn * BM; ldc = D; }
        else { base = d0 + (size_t)(NCTX + u.z * 1024 + u.pm * BM) * D + u.pn * BM; ldc = D; }
        bf16_t* p0 = base + (size_t)(wr * 64 + fr) * ldc + wc * 32 + 8 * fq;
        const __amdgpu_buffer_rsrc_t rsrc = __builtin_amdgcn_make_buffer_rsrc(wsb, 0, 0x7fffffff, 0x00020000);
        const unsigned off0 = (unsigned)((const unsigned char*)p0 - wsb);
#pragma unroll
        for (int ai = 0; ai < 2; ++ai)
#pragma unroll
            for (int m = 0; m < 4; ++m) {
                const unsigned roff = off0 + (unsigned)((ai * HALF + m * 16) * ldc) * 2u;
#pragma unroll
                for (int bj = 0; bj < 2; ++bj) { const f32x4 v0 = acc[ai][bj][m][0], v1 = acc[ai][bj][m][1];
                    u32x4 w; w.x = cvt_pk_bf16(v0[0], v0[1]); w.y = cvt_pk_bf16(v0[2], v0[3]); w.z = cvt_pk_bf16(v1[0], v1[1]); w.w = cvt_pk_bf16(v1[2], v1[3]);
                    __builtin_amdgcn_raw_buffer_store_b128(w, rsrc, roff + (unsigned)(bj * HALF * 2), 0, 16); }
            }
    }
};

template <class Epi, int MT = 4, bool ALIGN_EPI = false, bool SP2 = false>
__device__ __forceinline__ void gemm_phase(LAS unsigned char* lds, const int tid, const Sched& S, const int nt, const Epi& E) {
    const int  wid = __builtin_amdgcn_readfirstlane(tid >> 6), lane = tid & 63, wr = wid >> 2, wc = wid & 3, fr = lane & 15, fq = lane >> 4;
    const int lda = S.lda, ldb = S.ldb;
    unsigned voffA[2], voffB[2];
#pragma unroll
    for (int i = 0; i < 2; ++i) { int R, C; stage_rc(tid * 16 + i * 8192, R, C); const int Rb = Epi::PERM ? ((R & ~31) + perm32(R & 31)) : R;
        const int Ra = (R >= 32 * MT) ? R - (128 - 32 * MT) : R;
        voffA[i] = (unsigned)(Ra * lda + C) * 2u; voffB[i] = (unsigned)(Rb * ldb + C) * 2u; }
    const size_t kstep = (size_t)(BK * 2);
    const size_t hstepA = (size_t)(32 * MT) * lda * 2, hstepB = (size_t)HALF * ldb * 2;
    const unsigned ldsw = (unsigned)wid * 1024u;
    const int aoff = lds_byte(wr * (16 * MT) + fr, fq * 8), boff = lds_byte(wc * 32 + fr, fq * 8);
#define PG8_SA(b, h) (((b) * 2 + (h)) * HTB)
#define PG8_SB(b, h) ((4 + (b) * 2 + (h)) * HTB)
#define PG8_STAGE(bufoff, gbase, voff) do { _Pragma("unroll") for (int _i = 0; _i < 2; ++_i) \
        __builtin_amdgcn_global_load_lds((const unsigned*)((const char*)(gbase) + (voff)[_i]), (LAS unsigned*)(lds + (bufoff) + ldsw + _i * 8192), 16, 0, 0); } while (0)
#define PG8_LDA(dst, b, h) do { _Pragma("unroll") for (int m = 0; m < MT; ++m) _Pragma("unroll") for (int k = 0; k < 2; ++k) dst[m][k] = *(const LAS bf16x8*)(lds + PG8_SA(b, h) + aoff + m * 2048 + k * 1024); } while (0)
#define PG8_LDB(dst, b, h) do { _Pragma("unroll") for (int n = 0; n < 2; ++n) _Pragma("unroll") for (int k = 0; k < 2; ++k) dst[n][k] = *(const LAS bf16x8*)(lds + PG8_SB(b, h) + boff + n * 2048 + k * 1024); } while (0)
#define PG8_MMA(ai, bj, At, Bt) do { __builtin_amdgcn_s_setprio(1); _Pragma("unroll") for (int m = 0; m < MT; ++m) _Pragma("unroll") for (int n = 0; n < 2; ++n) _Pragma("unroll") for (int k = 0; k < 2; ++k) \
        acc[ai][bj][m][n] = __builtin_amdgcn_mfma_f32_16x16x32_bf16(Bt[n][k], At[m][k], acc[ai][bj][m][n], 0, 0, 0); __builtin_amdgcn_s_setprio(0); } while (0)
#define PG8_WAIT_V(n) asm volatile("s_waitcnt vmcnt(" #n ")" ::: "memory")
#define PG8_WAIT_L(n) asm volatile("s_waitcnt lgkmcnt(" #n ")" ::: "memory")
#define PG8_BAR __builtin_amdgcn_s_barrier()
#define PG8_SCHED __builtin_amdgcn_sched_barrier(0)
    Unit cur, nxt; int ui = 0;
    if (!S.next(0, cur)) return;
    f32x4 acc[2][2][MT][2];
    float zz = 0.f; asm volatile("" : "+v"(zz));
#pragma unroll
    for (int a = 0; a < 2; ++a)
#pragma unroll
        for (int b = 0; b < 2; ++b)
#pragma unroll
            for (int m = 0; m < MT; ++m)
#pragma unroll
                for (int n = 0; n < 2; ++n) acc[a][b][m][n] = (f32x4){zz, zz, zz, zz};
    bf16x8 At[MT][2], B0[2][2], B1[2][2];
    const char* cA = cur.A; const char* cB = cur.B;
    if constexpr (SP2) {
        PG8_STAGE(PG8_SB(0, 0), cB, voffB); PG8_STAGE(PG8_SB(0, 1), cB + hstepB, voffB); PG8_STAGE(PG8_SA(0, 0), cA, voffA); PG8_STAGE(PG8_SA(0, 1), cA + hstepA, voffA);
        if (wr == 1) PG8_BAR;
        PG8_WAIT_V(2); PG8_BAR;
        PG8_STAGE(PG8_SB(1, 0), cB + kstep, voffB); PG8_STAGE(PG8_SA(1, 0), cA + kstep, voffA); PG8_STAGE(PG8_SB(1, 1), cB + hstepB + kstep, voffB);
        PG8_WAIT_V(6); PG8_BAR;
    } else {
    PG8_STAGE(PG8_SB(0, 0), cB, voffB); PG8_STAGE(PG8_SA(0, 0), cA, voffA); PG8_STAGE(PG8_SB(0, 1), cB + hstepB, voffB); PG8_STAGE(PG8_SA(0, 1), cA + hstepA, voffA);
    if (wr == 1) PG8_BAR;
    PG8_WAIT_V(4); PG8_BAR;
    PG8_STAGE(PG8_SB(1, 0), cB + kstep, voffB); PG8_STAGE(PG8_SA(1, 0), cA + kstep, voffA); PG8_STAGE(PG8_SB(1, 1), cB + hstepB + kstep, voffB);
    PG8_WAIT_V(6); PG8_BAR;
    }
    for (;;) {
        const bool has_next = S.next(ui + 1, nxt);
        const char* nA = has_next ? nxt.A : cA; const char* nB = has_next ? nxt.B : cB;
        for (int t = 0; t < nt; t += 2) {
            const bool last = (t == nt - 2);
            const char* a1 = cA + (size_t)(t + 1) * kstep;
            const char* a2 = last ? nA : cA + (size_t)(t + 2) * kstep; const char* b2 = last ? nB : cB + (size_t)(t + 2) * kstep;
            const char* a3 = a2 + kstep; const char* b3 = b2 + kstep;
            if constexpr (SP2) {
            PG8_LDB(B0, 0, 0); PG8_LDB(B1, 0, 1); PG8_SCHED; PG8_LDA(At, 0, 0); PG8_STAGE(PG8_SA(1, 1), a1 + hstepA, voffA);
            PG8_WAIT_V(8); PG8_WAIT_L(0); PG8_BAR; PG8_MMA(0, 0, At, B0); PG8_MMA(0, 1, At, B1); PG8_BAR; PG8_SCHED;
            PG8_LDA(At, 0, 1); PG8_STAGE(PG8_SB(0, 0), b2, voffB); PG8_STAGE(PG8_SB(0, 1), b2 + hstepB, voffB); PG8_STAGE(PG8_SA(0, 0), a2, voffA);
            PG8_WAIT_V(8); PG8_WAIT_L(0); PG8_BAR; PG8_MMA(1, 0, At, B0); PG8_MMA(1, 1, At, B1); PG8_BAR; PG8_SCHED;
            PG8_LDB(B0, 1, 0); PG8_LDB(B1, 1, 1); PG8_SCHED; PG8_LDA(At, 1, 0); PG8_STAGE(PG8_SA(0, 1), a2 + hstepA, voffA);
            PG8_WAIT_V(8); PG8_WAIT_L(0); PG8_BAR; PG8_MMA(0, 0, At, B0); PG8_MMA(0, 1, At, B1); PG8_BAR; PG8_SCHED;
            PG8_LDA(At, 1, 1); PG8_STAGE(PG8_SB(1, 0), b3, voffB); PG8_STAGE(PG8_SB(1, 1), b3 + hstepB, voffB); PG8_STAGE(PG8_SA(1, 0), a3, voffA);
            PG8_WAIT_V(8); PG8_WAIT_L(0); PG8_BAR; PG8_MMA(1, 0, At, B0); PG8_MMA(1, 1, At, B1); PG8_BAR; PG8_SCHED;
            } else {
            PG8_LDB(B0, 0, 0); PG8_SCHED; PG8_LDA(At, 0, 0); PG8_STAGE(PG8_SA(1, 1), a1 + hstepA, voffA);
            PG8_WAIT_L(8); PG8_BAR; PG8_WAIT_L(0); PG8_MMA(0, 0, At, B0); PG8_BAR; PG8_SCHED;
            PG8_LDB(B1, 0, 1); PG8_STAGE(PG8_SB(0, 0), b2, voffB);
            PG8_BAR; PG8_WAIT_L(0); PG8_MMA(0, 1, At, B1); PG8_BAR;
            PG8_LDA(At, 0, 1); PG8_STAGE(PG8_SA(0, 0), a2, voffA);
            PG8_BAR; PG8_WAIT_L(0); PG8_MMA(1, 0, At, B0); PG8_BAR; PG8_SCHED;
            PG8_STAGE(PG8_SB(0, 1), b2 + hstepB, voffB);
            PG8_WAIT_V(6); PG8_BAR; PG8_MMA(1, 1, At, B1); PG8_BAR;
            PG8_LDB(B0, 1, 0); PG8_SCHED; PG8_LDA(At, 1, 0); PG8_STAGE(PG8_SA(0, 1), a2 + hstepA, voffA);
            PG8_WAIT_L(8); PG8_BAR; PG8_WAIT_L(0); PG8_MMA(0, 0, At, B0); PG8_BAR; PG8_SCHED;
            PG8_LDB(B1, 1, 1); PG8_STAGE(PG8_SB(1, 0), b3, voffB);
            PG8_BAR; PG8_WAIT_L(0); PG8_MMA(0, 1, At, B1); PG8_BAR;
            PG8_LDA(At, 1, 1); PG8_STAGE(PG8_SA(1, 0), a3, voffA);
            PG8_BAR; PG8_WAIT_L(0); PG8_MMA(1, 0, At, B0); PG8_BAR; PG8_SCHED;
            PG8_STAGE(PG8_SB(1, 1), b3 + hstepB, voffB);
            PG8_WAIT_V(6); PG8_BAR; PG8_MMA(1, 1, At, B1); PG8_BAR;
            }
        }
        if constexpr (ALIGN_EPI) { if (wr == 0) PG8_BAR; }
        E(acc, cur, wr, wc, fr, fq);
        if (!has_next) break;
#pragma unroll
        for (int a = 0; a < 2; ++a)
#pragma unroll
            for (int b = 0; b < 2; ++b)
#pragma unroll
                for (int m = 0; m < MT; ++m)
#pragma unroll
                    for (int n = 0; n < 2; ++n) acc[a][b][m][n] = (f32x4){zz, zz, zz, zz};
        cur = nxt; cA = nA; cB = nB; ++ui;
        if constexpr (ALIGN_EPI) { if (wr == 1) PG8_BAR; }
    }
    PG8_WAIT_V(0);
    if constexpr (!ALIGN_EPI) { if (wr == 0) PG8_BAR; }
    PG8_BAR;
#undef PG8_SA
#undef PG8_SB
#undef PG8_STAGE
#undef PG8_LDA
#undef PG8_LDB
#undef PG8_MMA
#undef PG8_WAIT_V
#undef PG8_WAIT_L
#undef PG8_BAR
#undef PG8_SCHED
}
}


#define XB_TMO      128
#define XB_XCNT(j)  (256  + 64 * (j))
#define XB_XSUB(j)  (1280 + 64 * (j))
#define XB_XGEN(j)  (2304 + 64 * (j))
#define XB_TOP      3328
#define XB_TOPGEN   3392
#define XCD_BAR_WORDS 3456
#define XB_SPIN_CAP (1u << 18)
__device__ __forceinline__ unsigned xb_ld(unsigned* p)              { return __hip_atomic_load(p, __ATOMIC_RELAXED, __HIP_MEMORY_SCOPE_AGENT); }
__device__ __forceinline__ unsigned xb_add(unsigned* p, unsigned v) { return __hip_atomic_fetch_add(p, v, __ATOMIC_RELAXED, __HIP_MEMORY_SCOPE_AGENT); }
__device__ __forceinline__ unsigned xb_xcc_id() { return (unsigned)__builtin_amdgcn_s_getreg((3 << 11) | 20) & 0xFu; }
#define XB_SPIN(cond, bar) do { unsigned _sp = 0; while (cond) { __builtin_amdgcn_s_sleep(1); \
    if ((++_sp & 255u) == 0u) { if (xb_ld(&(bar)[XB_TMO])) break; if (_sp > XB_SPIN_CAP) { atomicAdd(&(bar)[XB_TMO], 1u); break; } } } } while (0)
struct XcdBarrier { unsigned* bar; unsigned x; volatile LAS unsigned* st; };
__device__ __forceinline__ XcdBarrier xcd_barrier_post(unsigned* bar, volatile LAS unsigned* st) {
    XcdBarrier b; b.bar = bar; b.x = xb_xcc_id(); b.st = st;
    if (threadIdx.x == 0) (void)xb_add(&bar[XB_XCNT(b.x)], 1u);
    return b;
}
__device__ __forceinline__ void xcd_barrier_complete(unsigned* bar, unsigned x, unsigned& nloc, unsigned& nx) {
    const unsigned G = gridDim.x * gridDim.y * gridDim.z;
    unsigned sum, cnt, mine, sp = 0u;
    for (;;) {
        sum = 0u; cnt = 0u; mine = 0u;
#pragma unroll
        for (unsigned j = 0; j < 16; ++j) { const unsigned c = xb_ld(&bar[XB_XCNT(j)]); sum += c; cnt += (c > 0u) ? 1u : 0u; mine = (j == x) ? c : mine; }
        if (sum == G) break;
        __builtin_amdgcn_s_sleep(1);
        if ((++sp & 255u) == 0u) { if (xb_ld(&bar[XB_TMO])) break; if (sp > XB_SPIN_CAP) { atomicAdd(&bar[XB_TMO], 1u); break; } }
    }
    nloc = mine > 0u ? mine : 1u; nx = cnt > 0u ? cnt : 1u;
}
__device__ __forceinline__ void xcd_barrier(const XcdBarrier& b) {
    asm volatile("s_waitcnt vmcnt(0)" ::: "memory");
    __syncthreads();
    if (threadIdx.x == 0) {
        unsigned* bar = b.bar;
        __builtin_amdgcn_s_waitcnt(0);
        unsigned nloc = b.st[0], nx = b.st[1];
        if (nloc == 0u) { xcd_barrier_complete(bar, b.x, nloc, nx); b.st[0] = nloc; b.st[1] = nx; }
        const unsigned old = xb_add(&bar[XB_XSUB(b.x)], 1u);
        const unsigned gen = old / nloc;
        if (old + 1u == (gen + 1u) * nloc) {
            __builtin_amdgcn_fence(__ATOMIC_RELEASE, "agent");
            asm volatile("s_waitcnt vmcnt(0)" ::: "memory");
            const unsigned og = xb_add(&bar[XB_TOP], 1u);
            const unsigned tg = og / nx;
            if (og + 1u == (tg + 1u) * nx) xb_add(&bar[XB_TOPGEN], 1u);
            else XB_SPIN(xb_ld(&bar[XB_TOPGEN]) == tg, bar);
            __builtin_amdgcn_fence(__ATOMIC_ACQUIRE, "agent");
            xb_add(&bar[XB_XGEN(b.x)], 1u);
            asm volatile("s_waitcnt vmcnt(0)" ::: "memory");
        } else {
            XB_SPIN(xb_ld(&bar[XB_XGEN(b.x)]) == gen, bar);
            __builtin_amdgcn_fence(__ATOMIC_ACQUIRE, "agent");
            asm volatile("s_waitcnt vmcnt(0)" ::: "memory");
        }
    }
    __syncthreads();
}

struct Args { const float* in[17]; float* out; unsigned char* ws; };
struct Frame {
    LAS unsigned char* lds; int tid, lane, wave;
    const float *xp, *xs, *state, *cnd, *cctx, *adaw, *adab, *npre, *npost, *wgu, *wdn, *fw, *gin, *ggu, *gbg, *gnorm, *gout;
    float* out; unsigned char* ws;
};
#define WSP(T, off) ((T*)(F.ws + (off)))

__device__ __forceinline__ void transpose_item(const float* W, int N, bf16_t* WT, int K, int dst_row0, LAS float* scr, int k0, int n0, int lane) {
    float v_[32];
#pragma unroll
    for (int i = 0; i < 32; ++i) { const int kk = 2 * i + (lane >> 5); v_[i] = __builtin_nontemporal_load(W + (size_t)(k0 + kk) * N + n0 + (lane & 31)); }
#pragma unroll
    for (int i = 0; i < 32; ++i) { const int kk = 2 * i + (lane >> 5); scr[kk * 33 + (lane & 31)] = v_[i]; }
    asm volatile("s_waitcnt lgkmcnt(0)" ::: "memory");
    const int c = lane & 7;
#pragma unroll
    for (int j = 0; j < 4; ++j) { const int n = (lane >> 3) + 8 * j; const LAS float* s = scr + (8 * c) * 33 + n;
        u32x4 o; o.x = cvt_pk_bf16(s[0 * 33], s[1 * 33]); o.y = cvt_pk_bf16(s[2 * 33], s[3 * 33]); o.z = cvt_pk_bf16(s[4 * 33], s[5 * 33]); o.w = cvt_pk_bf16(s[6 * 33], s[7 * 33]);
        *(u32x4*)(WT + (size_t)(dst_row0 + n) * K + k0 + 8 * c) = o; }
    asm volatile("s_waitcnt lgkmcnt(0)" ::: "memory");
}


__device__ __forceinline__ void convert_ffn(Frame& F, int f, int part, int nparts) {
    LAS float* scr = (LAS float*)(F.lds + F.wave * 16384);
    const int gw = part * 8 + F.wave, NGW = nparts * 8, lane = F.lane;
    constexpr int I1 = 32 * 352, I2 = 88 * 64;
    for (int it = gw; it < I1 + I2; it += NGW) {
        int r = it;
        if (r < I1) { const int kb = r / 352, nb = r % 352, n0 = nb * 32;
            const int dr = (n0 < FF) ? ((n0 >> 7) * 256 + (n0 & 127)) : ((((n0 - FF) >> 7) * 256) + 128 + ((n0 - FF) & 127));
            transpose_item(F.wgu + (size_t)f * D * 11264, 11264, WSP(bf16_t, WS_W1) + (size_t)f * W1_ELEMS, D, dr, scr, kb * 64, n0, lane); continue; }
        r -= I1;
        { const int kb = r / 64, nb = r % 64; transpose_item(F.wdn + (size_t)f * FF * D, D, WSP(bf16_t, WS_W2) + (size_t)f * W2_ELEMS, FF, nb * 32, scr, kb * 64, nb * 32, lane); }
    }
}
template <int WHAT>
__device__ __forceinline__ void convert_misc(Frame& F, int part, int nparts) {
    LAS float* scr = (LAS float*)(F.lds + F.wave * 16384);
    const int gw = part * 8 + F.wave, NGW = nparts * 8, lane = F.lane;
    constexpr int I3 = 32 * 64, I5 = 32 * 257;
    for (int it = gw; it < 2 * I3 + I5; it += NGW) {
        int r = it;
        if (r < I3) { if (WHAT & 1) { const int kb = r / 64, nb = r % 64; transpose_item(F.fw, D, WSP(bf16_t, WS_FW), D, nb * 32, scr, kb * 64, nb * 32, lane); } continue; }
        r -= I3;
        if (r < I3) { if (WHAT & 2) { const int kb = r / 64, nb = r % 64; transpose_item(F.gout, D, WSP(bf16_t, WS_WO), D, nb * 32, scr, kb * 64, nb * 32, lane); } continue; }
        r -= I3;
        if (WHAT & 4) { const int kb = r / 257, nb = r % 257, n0 = nb * 32;
          if (n0 < 4096) transpose_item(F.gin, 8224, WSP(bf16_t, WS_WA), D, n0, scr, kb * 64, n0, lane);
          else if (n0 < 6144) transpose_item(F.gin, 8224, WSP(bf16_t, WS_WV), D, n0 - 4096, scr, kb * 64, n0, lane);
          else transpose_item(F.gin, 8224, WSP(bf16_t, WS_WA), D, n0 - 2048, scr, kb * 64, n0, lane); }
    }
    const size_t gt = (size_t)part * 512 + F.tid, NT = (size_t)nparts * 512;
    if (WHAT & 4) { u32x4* wz = (u32x4*)(WSP(bf16_t, WS_WA) + (size_t)6176 * D);
        for (size_t e = gt; e < (size_t)224 * D / 8; e += NT) wz[e] = (u32x4){0u, 0u, 0u, 0u}; }
}

__device__ __forceinline__ void prologue(Frame& F) {
    const int tid = F.tid, lane = F.lane, wave = F.wave, G = gridDim.x;
    {
        LAS float* Ss = (LAS float*)F.lds;
        LAS float* Red = (LAS float*)(F.lds + 24576);
        for (int e = tid; e < 3 * D; e += 512) { const int c = e >> 11, k = e & 2047; const float v = (c == 0) ? F.cctx[k] : F.cnd[(c - 1) * D + k]; Ss[e] = v / (1.0f + __expf(-v)); }
        __syncthreads();
        float* MOD = WSP(float, WS_MOD);
        for (int it = blockIdx.x; it < 256; it += G) {
            const int l = it >> 7, col0 = (it & 127) * 144; const bool on = lane < 36;
            const float* Wp = F.adaw + (size_t)l * D * NMOD + (size_t)(wave * 256) * NMOD + col0 + 4 * (on ? lane : 0);
            f32x4 a0 = {0.f, 0.f, 0.f, 0.f}, a1 = a0, a2 = a0;
            if (on) {
                for (int kb = 0; kb < 256; kb += 16) {
                    f32x4 w[16];
#pragma unroll
                    for (int j = 0; j < 16; ++j) w[j] = __builtin_nontemporal_load((const f32x4*)(Wp + (size_t)(kb + j) * NMOD));
#pragma unroll
                    for (int j = 0; j < 16; ++j) { const int k = wave * 256 + kb + j; const float s0 = Ss[k], s1 = Ss[D + k], s2 = Ss[2 * D + k];
                        a0 += w[j] * s0; a1 += w[j] * s1; a2 += w[j] * s2; }
                }
                *(LAS f32x4*)(Red + (wave * 3 + 0) * 144 + 4 * lane) = a0; *(LAS f32x4*)(Red + (wave * 3 + 1) * 144 + 4 * lane) = a1; *(LAS f32x4*)(Red + (wave * 3 + 2) * 144 + 4 * lane) = a2;
            }
            __syncthreads();
            if (tid < 432) { const int c = tid / 144, n = tid % 144; float s = 0.f;
#pragma unroll
                for (int w8 = 0; w8 < 8; ++w8) s += Red[(w8 * 3 + c) * 144 + n];
                MOD[(size_t)(l * 3 + c) * NMOD + col0 + n] = s + F.adab[(size_t)l * NMOD + col0 + n]; }
            __syncthreads();
        }
    }
    convert_ffn(F, 0, blockIdx.x, G);
    {
        const size_t gt = (size_t)blockIdx.x * 512 + tid, NT = (size_t)G * 512;
        for (size_t e = gt; e < (size_t)1024 * 64; e += NT) { const int row = (int)(e >> 6), k0 = (int)(e & 63) * 8, n = row & 511; const bool sn = row >= 512; float v[8];
#pragma unroll
            for (int j = 0; j < 8; ++j) { const int m = (n * (k0 + j)) & 511; float s, c; sincospif((float)m * (1.0f / 256.0f), &s, &c); v[j] = (sn ? s : c) * 0.044194173824159216f; }
            u32x4 o; o.x = cvt_pk_bf16(v[0], v[1]); o.y = cvt_pk_bf16(v[2], v[3]); o.z = cvt_pk_bf16(v[4], v[5]); o.w = cvt_pk_bf16(v[6], v[7]);
            *(u32x4*)(WSP(bf16_t, WS_FCT) + (size_t)row * 512 + k0) = o; }
        for (size_t e = gt; e < (size_t)256 * 64; e += NT) { const int row = (int)(e >> 6), k0 = (int)(e & 63) * 8; float v[8];
#pragma unroll
            for (int j = 0; j < 8; ++j) { const int kk = k0 + j, s_ = kk & 255; const int m = (row * s_) & 255; float s, c; sincospif((float)m * (1.0f / 128.0f), &s, &c); v[j] = (kk >= 256 ? -s : c) * 0.0625f; }
            u32x4 o; o.x = cvt_pk_bf16(v[0], v[1]); o.y = cvt_pk_bf16(v[2], v[3]); o.z = cvt_pk_bf16(v[4], v[5]); o.w = cvt_pk_bf16(v[6], v[7]);
            *(u32x4*)(WSP(bf16_t, WS_CTC) + (size_t)row * 512 + k0) = o; }
        for (size_t e = gt; e < (size_t)1024 * 256; e += NT) { const int row = (int)(e >> 8), k0 = (int)(e & 255) * 8; float v[8];
#pragma unroll
            for (int j = 0; j < 8; ++j) { const int kk = k0 + j, s_ = kk & 1023; const int m = (row * s_) & 1023; float s, c; sincospif((float)m * (1.0f / 512.0f), &s, &c); v[j] = (kk >= 1024 ? -s : c) * 0.03125f; }
            u32x4 o; o.x = cvt_pk_bf16(v[0], v[1]); o.y = cvt_pk_bf16(v[2], v[3]); o.z = cvt_pk_bf16(v[4], v[5]); o.w = cvt_pk_bf16(v[6], v[7]);
            *(u32x4*)(WSP(bf16_t, WS_CTL) + (size_t)row * 2048 + k0) = o; }
    }
}

__device__ __forceinline__ void elem_phase(Frame& F, int s) {
    const int gw = blockIdx.x * 8 + F.wave, NGW = gridDim.x * 8, lane = F.lane;
    const float* MOD = WSP(float, WS_MOD); const float* SQ = WSP(float, WS_SQ); const bf16_t* OUTB = WSP(bf16_t, WS_OUTF); bf16_t* HB = WSP(bf16_t, WS_HB);
    float* COMB = WSP(float, WS_COMB);
    if (s == 0) {
        for (int idx = gw; idx < 54 * 8; idx += NGW) { const int t = idx >> 3, col = (idx & 7) * 256 + 4 * lane, v = t % 3, k = (t / 3) % 3, cc = (t / 9) % 3, l = t / 27;
            const float* m = MOD + (size_t)(l * 3 + cc) * NMOD; f32x4 r;
            if (v == 0) { const float w = (k == 1) ? 1.0f : 0.5f; r = *(const f32x4*)(m + (3 * k + 2) * D + col) * *(const f32x4*)(F.npost + (size_t)(l * 3 + k) * D + col) * w; }
            else if (v == 1) r = *(const f32x4*)(F.npre + (size_t)(l * 3 + k) * D + col) * (*(const f32x4*)(m + (3 * k + 1) * D + col) + 1.0f);
            else r = *(const f32x4*)(m + (3 * k) * D + col);
            *(f32x4*)(COMB + (size_t)t * D + col) = r; }
        for (int r = gw; r < MROWS; r += NGW) {
            const int cidx = r < NCTX ? 0 : 1 + ((r - NCTX) >> 10);
            const float* xin = r < NCTX ? F.xp + (size_t)r * D : F.xs + (size_t)(r - NCTX) * D;
            f32x4 x[8], g[8], a[8], b[8];
            const f32x4* gpr = (const f32x4*)F.npre; const f32x4* sh = (const f32x4*)(MOD + (size_t)cidx * NMOD); const f32x4* sc = (const f32x4*)(MOD + (size_t)cidx * NMOD + D);
#pragma unroll
            for (int j = 0; j < 8; ++j) { x[j] = ((const f32x4*)xin)[lane + 64 * j]; g[j] = gpr[lane + 64 * j]; a[j] = sh[lane + 64 * j]; b[j] = sc[lane + 64 * j]; }
            float ss = 0.f;
#pragma unroll
            for (int j = 0; j < 8; ++j) ss += (x[j][0] * x[j][0] + x[j][1] * x[j][1]) + (x[j][2] * x[j][2] + x[j][3] * x[j][3]);
            const float rr = rsqrtf(wave_sum(ss) * (1.0f / D) + EPS);
            u32x2* hb = (u32x2*)(HB + (size_t)r * D);
#pragma unroll
            for (int j = 0; j < 8; ++j) { const f32x4 h = x[j] * rr * g[j] * (b[j] + 1.0f) + a[j]; u32x2 o; o.x = cvt_pk_bf16(h[0], h[1]); o.y = cvt_pk_bf16(h[2], h[3]); hb[lane + 64 * j] = o; }
        }
        return;
    }
    const int lp = (s - 1) / 3, kp = (s - 1) % 3, l = s / 3, k = s % 3;
    for (int r = gw; r < MROWS; r += NGW) {
        const int cidx = r < NCTX ? 0 : 1 + ((r - NCTX) >> 10);
        const float* xin = (s <= 1) ? (r < NCTX ? F.xp + (size_t)r * D : F.xs + (size_t)(r - NCTX) * D) : F.out + (size_t)r * D;
        const f32x4* Gp = (const f32x4*)(COMB + (size_t)(((lp * 3 + cidx) * 3 + kp) * 3 + 0) * D);
        const f32x4* Ap = (const f32x4*)(COMB + (size_t)(((l * 3 + cidx) * 3 + k) * 3 + 1) * D);
        const f32x4* Bp = (const f32x4*)(COMB + (size_t)(((l * 3 + cidx) * 3 + k) * 3 + 2) * D);
        const u32x2* o4 = (const u32x2*)(OUTB + (size_t)r * D);
        f32x4 x[8], g[8], a[8], b[8]; u32x2 ov[8];
        const float part = lane < 32 ? SQ[(size_t)r * 32 + lane] : 0.f;
#pragma unroll
        for (int j = 0; j < 8; ++j) { x[j] = ((const f32x4*)xin)[lane + 64 * j]; ov[j] = o4[lane + 64 * j]; g[j] = Gp[lane + 64 * j]; }
        if (s < 6) {
#pragma unroll
            for (int j = 0; j < 8; ++j) { a[j] = Ap[lane + 64 * j]; b[j] = Bp[lane + 64 * j]; }
        }
        const float rs = rsqrtf(wave_sum(part) * (1.0f / D) + EPS);
#pragma unroll
        for (int j = 0; j < 8; ++j) {
            const f32x4 o = {__uint_as_float(ov[j].x << 16), __uint_as_float(ov[j].x & 0xffff0000u), __uint_as_float(ov[j].y << 16), __uint_as_float(ov[j].y & 0xffff0000u)};
            x[j] += g[j] * (o * rs); }
#pragma unroll
        for (int j = 0; j < 8; ++j) ((f32x4*)(F.out + (size_t)r * D))[lane + 64 * j] = x[j];
        if (s == 4 && lane < 32) WSP(float, WS_LR)[(size_t)r * 32 + lane] = 0.f;
        if (s < 6) {
            float ss = 0.f;
#pragma unroll
            for (int j = 0; j < 8; ++j) ss += (x[j][0] * x[j][0] + x[j][1] * x[j][1]) + (x[j][2] * x[j][2] + x[j][3] * x[j][3]);
            const float rr = rsqrtf(wave_sum(ss) * (1.0f / D) + EPS);
            u32x2* hb = (u32x2*)(HB + (size_t)r * D);
#pragma unroll
            for (int j = 0; j < 8; ++j) { const f32x4 h = x[j] * rr * a[j] + b[j]; u32x2 o; o.x = cvt_pk_bf16(h[0], h[1]); o.y = cvt_pk_bf16(h[2], h[3]); hb[lane + 64 * j] = o; }
        }
    }
}

constexpr size_t WS_PCNT = 65536;
__device__ __forceinline__ void fused_elem(Frame& F, const int s, const int slot, const int pm, const int pn) {
    const int lane = F.lane, rbase = pm * 192 + pn * 24 + F.wave * 3;
    const bf16_t* OUTB = WSP(bf16_t, WS_OUTF); const float* SQ = WSP(float, WS_SQ); bf16_t* HB = WSP(bf16_t, WS_HB); const float* COMB = WSP(float, WS_COMB);
    f32x4 x[3][8];
#pragma unroll
    for (int q = 0; q < 3; ++q) { const int r = rbase + q;
        const float* xin = (s <= 1) ? (r < NCTX ? F.xp + (size_t)r * D : F.xs + (size_t)(r - NCTX) * D) : F.out + (size_t)r * D;
#pragma unroll
        for (int j = 0; j < 8; ++j) x[q][j] = ((const f32x4*)xin)[lane + 64 * j]; }
    unsigned* cnt = (unsigned*)(F.ws + WS_PCNT + (size_t)(slot * 32 + pm) * 256);
    asm volatile("s_waitcnt vmcnt(0)" ::: "memory");
    __syncthreads();
    if (F.tid == 0) {
        __hip_atomic_fetch_add(cnt, 1u, __ATOMIC_RELAXED, __HIP_MEMORY_SCOPE_AGENT);
        unsigned sp = 0;
        while (__hip_atomic_load(cnt, __ATOMIC_RELAXED, __HIP_MEMORY_SCOPE_AGENT) < 8u) { __builtin_amdgcn_s_sleep(1); if (++sp > (1u << 22)) break; }
        __builtin_amdgcn_fence(__ATOMIC_ACQUIRE, "agent");
        asm volatile("s_waitcnt vmcnt(0)" ::: "memory");
    }
    __syncthreads();
    const int lp = (s - 1) / 3, kp = (s - 1) % 3, l = s / 3, k = s % 3;
#pragma unroll
    for (int q = 0; q < 3; ++q) { const int r = rbase + q;
        const int cidx = r < NCTX ? 0 : 1 + ((r - NCTX) >> 10);
        const f32x4* Gp = (const f32x4*)(COMB + (size_t)(((lp * 3 + cidx) * 3 + kp) * 3 + 0) * D);
        const f32x4* Ap = (const f32x4*)(COMB + (size_t)(((l * 3 + cidx) * 3 + k) * 3 + 1) * D);
        const f32x4* Bp = (const f32x4*)(COMB + (size_t)(((l * 3 + cidx) * 3 + k) * 3 + 2) * D);
        const u32x2* o4 = (const u32x2*)(OUTB + (size_t)r * D);
        f32x4 g[8], a[8], b[8]; u32x2 ov[8];
        const float part = lane < 32 ? __hip_atomic_load(SQ + (size_t)r * 32 + lane, __ATOMIC_RELAXED, __HIP_MEMORY_SCOPE_AGENT) : 0.f;
#pragma unroll
        for (int j = 0; j < 8; ++j) { ov[j] = o4[lane + 64 * j]; g[j] = Gp[lane + 64 * j]; }
        if (s < 6) {
#pragma unroll
            for (int j = 0; j < 8; ++j) { a[j] = Ap[lane + 64 * j]; b[j] = Bp[lane + 64 * j]; }
        }
        const float rs = rsqrtf(wave_sum(part) * (1.0f / D) + EPS);
#pragma unroll
        for (int j = 0; j < 8; ++j) {
            const f32x4 o = {__uint_as_float(ov[j].x << 16), __uint_as_float(ov[j].x & 0xffff0000u), __uint_as_float(ov[j].y << 16), __uint_as_float(ov[j].y & 0xffff0000u)};
            x[q][j] += g[j] * (o * rs); }
#pragma unroll
        for (int j = 0; j < 8; ++j) ((f32x4*)(F.out + (size_t)r * D))[lane + 64 * j] = x[q][j];
        if (s == 4 && lane < 32) WSP(float, WS_LR)[(size_t)r * 32 + lane] = 0.f;
        if (s < 6) {
            float ss = 0.f;
#pragma unroll
            for (int j = 0; j < 8; ++j) ss += (x[q][j][0] * x[q][j][0] + x[q][j][1] * x[q][j][1]) + (x[q][j][2] * x[q][j][2] + x[q][j][3] * x[q][j][3]);
            const float rr = rsqrtf(wave_sum(ss) * (1.0f / D) + EPS);
            u32x2* hb = (u32x2*)(HB + (size_t)r * D);
#pragma unroll
            for (int j = 0; j < 8; ++j) { const f32x4 h = x[q][j] * rr * a[j] + b[j]; u32x2 o; o.x = cvt_pk_bf16(h[0], h[1]); o.y = cvt_pk_bf16(h[2], h[3]); hb[lane + 64 * j] = o; }
        }
    }
}

__device__ __forceinline__ void g2_phase(Frame& F) {
    LAS float* Gs = (LAS float*)F.lds;
    LAS float* Tot = (LAS float*)(F.lds + 65536);
    LAS float* LRs = (LAS float*)(F.lds + 65536 + 2048);
    LAS bf16_t* KHs = (LAS bf16_t*)(F.lds + 65536 + 2048 + 4096);
    const int tid = F.tid, ch = tid & 255, th = __builtin_amdgcn_readfirstlane(tid >> 8);
    const bf16_t* P = WSP(bf16_t, WS_P); bf16_t* QT = WSP(bf16_t, WS_QT); bf16_t* KT = WSP(bf16_t, WS_KT); bf16_t* KHT = WSP(bf16_t, WS_KHT); float* EL = WSP(float, WS_EL);
    for (int it = blockIdx.x; it < 768; it += gridDim.x) {
        const int cgk = it >> 3, d = (it >> 2) & 1, h = it & 3;
        int b, c, row0, lat;
        if (cgk < 64) { b = cgk >> 2; c = cgk & 3; row0 = b * 256 + c * 64; lat = 0; } else { const int cl = cgk - 64; b = cl >> 4; c = cl & 15; row0 = NCTX + b * 1024 + c * 64; lat = 1; }
        const int chd = h * 256 + ch;
        for (int e = tid; e < 1024; e += 512) { const int i = e >> 4, rk = e & 15; LRs[e] = WSP(float, WS_LR)[(size_t)(row0 + i) * 32 + d * 16 + rk]; }
        float wg[16];
#pragma unroll
        for (int rk = 0; rk < 16; ++rk) wg[rk] = F.ggu[(size_t)(d * 16 + rk) * 1024 + chd];
        const float bg = F.gbg[d * 1024 + chd];
        __syncthreads();
        float run = 0.f;
        for (int ii = 0; ii < 32; ++ii) {
            const int i = d == 0 ? th * 32 + ii : th * 32 + 31 - ii;
            float xg = bg;
#pragma unroll
            for (int q4 = 0; q4 < 4; ++q4) { const f32x4 l4 = *(const LAS f32x4*)(LRs + i * 16 + q4 * 4);
                xg += l4[0] * wg[q4 * 4] + l4[1] * wg[q4 * 4 + 1] + l4[2] * wg[q4 * 4 + 2] + l4[3] * wg[q4 * 4 + 3]; }
            const float g = (fminf(xg, 0.f) - __logf(1.0f + __expf(-fabsf(xg)))) * 0.0625f;
            run += g; Gs[i * 256 + ch] = run;
        }
        Tot[th * 256 + ch] = run;
        __syncthreads();
        const float tot0 = Tot[ch], tot1 = Tot[256 + ch], total = tot0 + tot1;
        const float fix = (d == 0) ? (th == 1 ? tot0 : 0.f) : (th == 0 ? tot1 : 0.f);
        const int p = ch >> 1;
        const float inv = exp2f(-(float)(p & 63) * (13.287712379549449f / 64.0f));
        const int qcol = (d ? 2048 : 0) + chd, kcol = (d ? 3072 : 1024) + chd;
        const float elc = __expf(total);
        bf16_t qraw[32], kraw[32];
#pragma unroll
        for (int ii = 0; ii < 32; ++ii) { const size_t row = (size_t)(row0 + th * 32 + ii); qraw[ii] = P[row * PLD + qcol]; kraw[ii] = P[row * PLD + kcol]; }
#pragma unroll
        for (int ii = 0; ii < 32; ++ii) {
            const int i = th * 32 + ii; const size_t row = (size_t)(row0 + i);
            const float bb = Gs[i * 256 + ch] + fix;
            float qv = bf2f(qraw[ii]), kv = bf2f(kraw[ii]);
            if (lat) {
                const float ang = (float)(p < 64 ? c : i) * inv; const float sn = __sinf(ang), cs = __cosf(ang);
                const float qo = __shfl_xor(qv, 1), ko = __shfl_xor(kv, 1);
                if (ch & 1) { qv = qo * sn + qv * cs; kv = ko * sn + kv * cs; } else { qv = qv * cs - qo * sn; kv = kv * cs - ko * sn; }
            }
            const float qt = qv * 0.0625f * __expf(bb), kt = kv * __expf(-bb), kh = kt * elc;
            QT[((size_t)d * MROWS + row) * 1024 + chd] = (bf16_t)(cvt_pk_bf16(qt, 0.f) & 0xffffu);
            KT[((size_t)d * MROWS + row) * 1024 + chd] = (bf16_t)(cvt_pk_bf16(kt, 0.f) & 0xffffu);
            KHs[ch * 72 + i] = (bf16_t)(cvt_pk_bf16(kh, 0.f) & 0xffffu);
        }
        if (th == 0) EL[(size_t)(d * 96 + cgk) * 1024 + chd] = elc;
        __syncthreads();
        { const int rch = tid >> 1, hf = tid & 1;
          bf16_t* dst = (lat ? KHT + (size_t)2 * 16 * 1024 * 256 + ((size_t)((d * 2 + b) * 1024 + h * 256 + rch)) * 1024 : KHT + ((size_t)((d * 16 + b) * 1024 + h * 256 + rch)) * 256) + c * 64 + hf * 32;
          const LAS u32x4* src = (const LAS u32x4*)(KHs + rch * 72 + hf * 32);
#pragma unroll
          for (int j = 0; j < 4; ++j) ((u32x4*)dst)[j] = src[j]; }
        __syncthreads();
    }
}

constexpr int SC_QS = 0, SC_KS = 33792, SC_STS = 67584, SC_KHS = 101376, SC_VS = 138240, SC_PS = 147456, SC_ELS = 156672;
__device__ __forceinline__ int scan_item(int c, int G, int k) {
    if (G == 256) { const int x = c & 7, y = c >> 3, vs = y & 7;
        if (y < 16) { if (k == 0) return ((x + 8 * (y >> 3)) << 3) | vs; if (k < 3) return 128 + (((x + 8 * ((y >> 3) * 2 + (k - 1))) << 3) | vs); return -1; }
        return k < 6 ? 128 + (((32 + x + 8 * (((y - 16) >> 3) * 6 + k)) << 3) | vs) : -1; }
    const int id = k * G + c; return id < 1152 ? id : -1;
}
__device__ __forceinline__ void scan_phase(Frame& F) {
    const int tid = F.tid, lane = F.lane, w = F.wave, fr = lane & 15, fq = lane >> 4;
    LAS unsigned char* lds = F.lds;
    const bf16_t* QT = WSP(bf16_t, WS_QT); const bf16_t* KT = WSP(bf16_t, WS_KT); const bf16_t* KHT = WSP(bf16_t, WS_KHT); const bf16_t* VT = WSP(bf16_t, WS_VT);
    const float* EL = WSP(float, WS_EL); bf16_t* O = WSP(bf16_t, WS_O);
    for (int kk_ = 0;; ++kk_) {
        const int id = scan_item(blockIdx.x, gridDim.x, kk_); if (id < 0) break;
        const int lat = id < 128, ii = lat ? id : id - 128, vs = ii & 7, d = (ii >> 3) & 1, h = (ii >> 4) & 3, b = ii >> 6;
        const int T = lat ? 1024 : 256, nch = T >> 6, rowb = lat ? NCTX + b * 1024 : b * 256;
        const bf16_t* Qp = QT + ((size_t)d * MROWS + rowb) * 1024 + h * 256;
        const bf16_t* Kp = KT + ((size_t)d * MROWS + rowb) * 1024 + h * 256;
        const bf16_t* KHp = lat ? KHT + (size_t)2 * 16 * 1024 * 256 + ((size_t)((d * 2 + b) * 1024 + h * 256)) * 1024 : KHT + ((size_t)((d * 16 + b) * 1024 + h * 256)) * 256;
        const bf16_t* Vp = lat ? VT + (size_t)16 * 2048 * 256 + ((size_t)(b * 2048 + h * 512 + vs * 64)) * 1024 : VT + ((size_t)(b * 2048 + h * 512 + vs * 64)) * 256;
        const float* ELp = EL + (size_t)(d * 96 + (lat ? 64 + b * 16 : b * 4)) * 1024 + h * 256;
        bf16_t* Op = O + ((size_t)d * MROWS + rowb) * D + h * 512 + vs * 64;
        f32x4 acc[2][4];
        float zz = 0.f; asm volatile("" : "+v"(zz));
        if (lat) { const float* S0 = F.state + ((size_t)((b * 2 + d) * 4 + h)) * 256 * 512 + vs * 64;
            int sb = (w * 32 + 4 * fq) * 512 + fr; asm volatile("" : "+v"(sb));
#pragma unroll
            for (int ct = 0; ct < 2; ++ct)
#pragma unroll
                for (int vt = 0; vt < 4; ++vt)
#pragma unroll
                    for (int jj = 0; jj < 4; ++jj) acc[ct][vt][jj] = S0[sb + (ct * 16 + jj) * 512 + vt * 16]; }
        else {
#pragma unroll
            for (int ct = 0; ct < 2; ++ct)
#pragma unroll
                for (int vt = 0; vt < 4; ++vt) acc[ct][vt] = (f32x4){zz, zz, zz, zz}; }
#define SC_WRITE_STS() do { _Pragma("unroll") for (int ct = 0; ct < 2; ++ct) _Pragma("unroll") for (int vt = 0; vt < 4; ++vt) { u32x2 o_; o_.x = cvt_pk_bf16(acc[ct][vt][0], acc[ct][vt][1]); o_.y = cvt_pk_bf16(acc[ct][vt][2], acc[ct][vt][3]); \
            *(LAS u32x2*)(lds + SC_STS + (vt * 16 + fr) * 528 + (w * 32 + ct * 16 + 4 * fq) * 2) = o_; } } while (0)
        SC_WRITE_STS();
        u32x4 pq[4], pk[4], ph[4], pv; f32x4 pe = {zz, zz, zz, zz};
#define SC_LOAD(cc) do { const int c_ = (cc); \
            _Pragma("unroll") for (int q = 0; q < 4; ++q) { const int e = tid + 512 * q, row = e >> 5, ck = e & 31; \
                pq[q] = *(const u32x4*)(Qp + (size_t)(c_ * 64 + row) * 1024 + ck * 8); pk[q] = *(const u32x4*)(Kp + (size_t)(c_ * 64 + row) * 1024 + ck * 8); } \
            _Pragma("unroll") for (int q = 0; q < 4; ++q) { const int e = tid + 512 * q, row = e >> 3, ck = e & 7; ph[q] = *(const u32x4*)(KHp + (size_t)row * T + c_ * 64 + ck * 8); } \
            { const int row = tid >> 3, ck = tid & 7; pv = *(const u32x4*)(Vp + (size_t)row * T + c_ * 64 + ck * 8); } \
            if (tid < 64) pe = *(const f32x4*)(ELp + (size_t)c_ * 1024 + tid * 4); } while (0)
#define SC_STORE() do { \
            _Pragma("unroll") for (int q = 0; q < 4; ++q) { const int e = tid + 512 * q, row = e >> 5, ck = e & 31; \
                *(LAS u32x4*)(lds + SC_QS + row * 528 + ck * 16) = pq[q]; *(LAS u32x4*)(lds + SC_KS + row * 528 + ck * 16) = pk[q]; } \
            _Pragma("unroll") for (int q = 0; q < 4; ++q) { const int e = tid + 512 * q, row = e >> 3, ck = e & 7; *(LAS u32x4*)(lds + SC_KHS + row * 144 + ck * 16) = ph[q]; } \
            { const int row = tid >> 3, ck = tid & 7; *(LAS u32x4*)(lds + SC_VS + row * 144 + ck * 16) = pv; } \
            if (tid < 64) *(LAS f32x4*)(lds + SC_ELS + tid * 16) = pe; } while (0)
        SC_LOAD(d == 0 ? 0 : nch - 1);
        const int itile = w >> 1, t2 = (w & 1) * 2;
        for (int s = 0; s < nch; ++s) {
            const int c = d == 0 ? s : nch - 1 - s;
            SC_STORE();
            __syncthreads();
            if (s + 1 < nch) SC_LOAD(d == 0 ? s + 1 : nch - 2 - s);
#define SC_LD8(dst, off) do { _Pragma("unroll") for (int kk = 0; kk < 8; ++kk) dst[kk] = *(const LAS bf16x8*)(lds + (off) + kk * 64); } while (0)
#define SC_MM8(accv, af, bf_) do { f32x4 acc2_ = {zz, zz, zz, zz}; _Pragma("unroll") for (int kk = 0; kk < 4; ++kk) { accv = __builtin_amdgcn_mfma_f32_16x16x32_bf16(af[kk], bf_[kk], accv, 0, 0, 0); \
        acc2_ = __builtin_amdgcn_mfma_f32_16x16x32_bf16(af[kk + 4], bf_[kk + 4], acc2_, 0, 0, 0); } accv += acc2_; } while (0)
#define SC_KEEP8(x) asm volatile("" :: "v"(x[0]), "v"(x[1]), "v"(x[2]), "v"(x[3]), "v"(x[4]), "v"(x[5]), "v"(x[6]), "v"(x[7]))
            bf16x8 qf[8], fa[8];
            const int qoff = SC_QS + (itile * 16 + fr) * 528 + fq * 16;
            const int jt0 = t2, jt1 = t2 + 1;
            const bool live0 = d == 0 ? (jt0 <= itile) : (jt0 >= itile), live1 = d == 0 ? (jt1 <= itile) : (jt1 >= itile);
            f32x4 sc0 = {zz, zz, zz, zz}, sc1 = {zz, zz, zz, zz};
            f32x4 oa[2]; oa[0] = (f32x4){zz, zz, zz, zz}; oa[1] = (f32x4){zz, zz, zz, zz};
            SC_LD8(qf, qoff);
            if (live0) { SC_LD8(fa, SC_KS + (jt0 * 16 + fr) * 528 + fq * 16); __builtin_amdgcn_sched_barrier(0); SC_MM8(sc0, fa, qf); SC_KEEP8(fa); __builtin_amdgcn_sched_barrier(0); }
            if (live1) { SC_LD8(fa, SC_KS + (jt1 * 16 + fr) * 528 + fq * 16); __builtin_amdgcn_sched_barrier(0); SC_MM8(sc1, fa, qf); SC_KEEP8(fa); __builtin_amdgcn_sched_barrier(0); }
            SC_LD8(fa, SC_STS + ((t2 + 0) * 16 + fr) * 528 + fq * 16); __builtin_amdgcn_sched_barrier(0); SC_MM8(oa[0], fa, qf); SC_KEEP8(fa); __builtin_amdgcn_sched_barrier(0);
            SC_LD8(fa, SC_STS + ((t2 + 1) * 16 + fr) * 528 + fq * 16); __builtin_amdgcn_sched_barrier(0); SC_MM8(oa[1], fa, qf); SC_KEEP8(fa); SC_KEEP8(qf); __builtin_amdgcn_sched_barrier(0);
            { const int iabs = itile * 16 + fr;
#pragma unroll
              for (int jj = 0; jj < 4; ++jj) { const int j0 = jt0 * 16 + 4 * fq + jj, j1 = jt1 * 16 + 4 * fq + jj;
                  const bool ok0 = live0 && (d == 0 ? (j0 <= iabs) : (j0 >= iabs)), ok1 = live1 && (d == 0 ? (j1 <= iabs) : (j1 >= iabs));
                  sc0[jj] = ok0 ? sc0[jj] : 0.f; sc1[jj] = ok1 ? sc1[jj] : 0.f; }
              u32x2 o0, o1; o0.x = cvt_pk_bf16(sc0[0], sc0[1]); o0.y = cvt_pk_bf16(sc0[2], sc0[3]); o1.x = cvt_pk_bf16(sc1[0], sc1[1]); o1.y = cvt_pk_bf16(sc1[2], sc1[3]);
              *(LAS u32x2*)(lds + SC_PS + (itile * 16 + fr) * 144 + (jt0 * 16 + 4 * fq) * 2) = o0;
              *(LAS u32x2*)(lds + SC_PS + (itile * 16 + fr) * 144 + (jt1 * 16 + 4 * fq) * 2) = o1; }
            __syncthreads();
            bf16x8 pf[2], va[2][2];
#pragma unroll
            for (int kk = 0; kk < 2; ++kk) pf[kk] = *(const LAS bf16x8*)(lds + SC_PS + (itile * 16 + fr) * 144 + kk * 64 + fq * 16);
#pragma unroll
            for (int v2 = 0; v2 < 2; ++v2)
#pragma unroll
                for (int kk = 0; kk < 2; ++kk) va[v2][kk] = *(const LAS bf16x8*)(lds + SC_VS + ((t2 + v2) * 16 + fr) * 144 + kk * 64 + fq * 16);
            __builtin_amdgcn_sched_barrier(0);
#pragma unroll
            for (int v2 = 0; v2 < 2; ++v2) { const int vt = t2 + v2;
#pragma unroll
                for (int kk = 0; kk < 2; ++kk) oa[v2] = __builtin_amdgcn_mfma_f32_16x16x32_bf16(va[v2][kk], pf[kk], oa[v2], 0, 0, 0);
                { u32x2 ob_; ob_.x = cvt_pk_bf16(oa[v2][0], oa[v2][1]); ob_.y = cvt_pk_bf16(oa[v2][2], oa[v2][3]); *(u32x2*)(Op + (size_t)(c * 64 + itile * 16 + fr) * D + vt * 16 + 4 * fq) = ob_; } }
            __builtin_amdgcn_sched_barrier(0);
            bf16x8 kf[2][2], vb[4][2]; f32x4 el4[2];
#pragma unroll
            for (int ct = 0; ct < 2; ++ct) { el4[ct] = *(const LAS f32x4*)(lds + SC_ELS + (w * 32 + ct * 16 + 4 * fq) * 4);
#pragma unroll
                for (int kk = 0; kk < 2; ++kk) kf[ct][kk] = *(const LAS bf16x8*)(lds + SC_KHS + (w * 32 + ct * 16 + fr) * 144 + kk * 64 + fq * 16); }
#pragma unroll
            for (int vt = 0; vt < 4; ++vt)
#pragma unroll
                for (int kk = 0; kk < 2; ++kk) vb[vt][kk] = *(const LAS bf16x8*)(lds + SC_VS + (vt * 16 + fr) * 144 + kk * 64 + fq * 16);
            __builtin_amdgcn_sched_barrier(0);
#pragma unroll
            for (int ct = 0; ct < 2; ++ct)
#pragma unroll
                for (int vt = 0; vt < 4; ++vt) { acc[ct][vt] = acc[ct][vt] * el4[ct];
#pragma unroll
                    for (int kk = 0; kk < 2; ++kk) acc[ct][vt] = __builtin_amdgcn_mfma_f32_16x16x32_bf16(kf[ct][kk], vb[vt][kk], acc[ct][vt], 0, 0, 0); }
#undef SC_LD8
#undef SC_MM8
#undef SC_KEEP8
            SC_WRITE_STS();
            __syncthreads();
        }
        if (!lat) { float* So = F.out + (size_t)MROWS * D + ((size_t)((b * 2 + d) * 4 + h)) * 256 * 512 + vs * 64;
            int sb = (w * 32 + 4 * fq) * 512 + fr; asm volatile("" : "+v"(sb));
#pragma unroll
            for (int ct = 0; ct < 2; ++ct)
#pragma unroll
                for (int vt = 0; vt < 4; ++vt)
#pragma unroll
                    for (int jj = 0; jj < 4; ++jj) So[sb + (ct * 16 + jj) * 512 + vt * 16] = acc[ct][vt][jj]; }
#undef SC_WRITE_STS
#undef SC_LOAD
#undef SC_STORE
    }
}

__device__ __forceinline__ void g4_phase(Frame& F) {
    const int gw = blockIdx.x * 8 + F.wave, NGW = gridDim.x * 8, lane = F.lane;
    const bf16_t* O = WSP(bf16_t, WS_O); const bf16_t* P = WSP(bf16_t, WS_P); bf16_t* ON = WSP(bf16_t, WS_ON);
    for (int r = gw; r < MROWS; r += NGW) {
        const u32x2* o0 = (const u32x2*)(O + (size_t)r * D); const u32x2* o1 = (const u32x2*)(O + ((size_t)MROWS + r) * D);
        const u32x2* rg = (const u32x2*)(P + (size_t)r * PLD + 4096);
        f32x4 o[8]; u32x2 oa_[8], ob_[8], rv_[8]; const f32x4 gn0 = ((const f32x4*)F.gnorm)[lane], gn1 = ((const f32x4*)F.gnorm)[lane + 64];
#pragma unroll
        for (int j = 0; j < 8; ++j) { oa_[j] = o0[lane + 64 * j]; ob_[j] = o1[lane + 64 * j]; rv_[j] = rg[lane + 64 * j]; }
#pragma unroll
        for (int j = 0; j < 8; ++j) { o[j][0] = __uint_as_float(oa_[j].x << 16) + __uint_as_float(ob_[j].x << 16); o[j][1] = __uint_as_float(oa_[j].x & 0xffff0000u) + __uint_as_float(ob_[j].x & 0xffff0000u);
            o[j][2] = __uint_as_float(oa_[j].y << 16) + __uint_as_float(ob_[j].y << 16); o[j][3] = __uint_as_float(oa_[j].y & 0xffff0000u) + __uint_as_float(ob_[j].y & 0xffff0000u); }
        float rr[4];
#pragma unroll
        for (int hh = 0; hh < 4; ++hh) { float s = 0.f;
#pragma unroll
            for (int j = 2 * hh; j < 2 * hh + 2; ++j) s += (o[j][0] * o[j][0] + o[j][1] * o[j][1]) + (o[j][2] * o[j][2] + o[j][3] * o[j][3]);
            rr[hh] = rsqrtf(wave_sum(s) * (1.0f / 512.0f) + EPS); }
        u32x2* on = (u32x2*)(ON + (size_t)r * D);
#pragma unroll
        for (int j = 0; j < 8; ++j) { const f32x4 gn = (j & 1) ? gn1 : gn0; const u32x2 rv = rv_[j];
            const float r0 = __uint_as_float(rv.x << 16), r1 = __uint_as_float(rv.x & 0xffff0000u), r2 = __uint_as_float(rv.y << 16), r3 = __uint_as_float(rv.y & 0xffff0000u);
            const f32x4 v = o[j] * rr[j >> 1] * gn;
            u32x2 w_; w_.x = cvt_pk_bf16(v[0] * silu_f(r0), v[1] * silu_f(r1)); w_.y = cvt_pk_bf16(v[2] * silu_f(r2), v[3] * silu_f(r3)); on[lane + 64 * j] = w_; }
    }
}

enum { K_PRO = 0, K_ELEM, K_SWI, K_F32, K_BF, K_G2, K_SCAN, K_G4 };

template <int kind, int arg>
__device__ __forceinline__ void stage_dispatch(Frame& F, const int G, const int c) {
        if (kind == K_PRO) prologue(F);
        else if (kind == K_ELEM) elem_phase(F, arg);
        else if (kind == K_SWI) {
            pg8::Sched S{}; S.A = (const char*)WSP(bf16_t, WS_HB); S.B = (const char*)(WSP(bf16_t, WS_W1) + (size_t)arg * W1_ELEMS); S.A2 = S.A; S.B2 = S.B; S.sAz = 0; S.sBz = 0;
            S.lda = D; S.ldb = D; S.nM = 24; S.nN = 44; S.nZ = 1; S.nM2 = 0; S.nN2 = 1; S.nwg = 24 * 44; S.G = G; S.c = c; S.bm = 256;
            pg8::EpiSwiGLU<4> E{WSP(bf16_t, WS_HID), 0, 0};
            if (arg == 3 && G == 256) {
                S.nwg = 1024;
                pg8::gemm_phase<pg8::EpiSwiGLU<4>, 4, GP_ALIGN, GP_SP2>(F.lds, F.tid, S, D / 64, E);
                pg8::Sched S2 = S; S2.A = S.A + (size_t)5120 * D * 2; S2.B = S.B + (size_t)36 * 256 * D * 2; S2.A2 = S2.A; S2.B2 = S2.B; S2.nM = 8; S2.nN = 8; S2.nwg = 64; S2.bm = 128;
                pg8::EpiSwiGLU<2> E2{WSP(bf16_t, WS_HID), 5120, 36};
                pg8::gemm_phase<pg8::EpiSwiGLU<2>, 2, false, GP_SP2>(F.lds, F.tid, S2, D / 64, E2);
            } else
            pg8::gemm_phase<pg8::EpiSwiGLU<4>, 4, GP_ALIGN, GP_SP2>(F.lds, F.tid, S, D / 64, E);
            if (arg < 3) { const int first = S.nwg % G; if (c >= first) { convert_ffn(F, arg + 1, c - first, G - first); if (arg == 1) convert_misc<2>(F, c - first, G - first); } }
        } else if (kind == K_F32) {
            pg8::Sched S{}; int nt;
            if (arg < 4) { S.A = (const char*)WSP(bf16_t, WS_HID); S.B = (const char*)(WSP(bf16_t, WS_W2) + (size_t)arg * W2_ELEMS); S.lda = FF; S.ldb = FF; nt = FF / 64; }
            else if (arg == 4) { S.A = (const char*)WSP(bf16_t, WS_FB); S.B = (const char*)WSP(bf16_t, WS_FW); S.lda = D; S.ldb = D; nt = D / 64; }
            else { S.A = (const char*)WSP(bf16_t, WS_ON); S.B = (const char*)WSP(bf16_t, WS_WO); S.lda = D; S.ldb = D; nt = D / 64; }
            S.A2 = S.A; S.B2 = S.B; S.sAz = 0; S.sBz = 0; S.nM = 32; S.nN = 8; S.nZ = 1; S.nM2 = 0; S.nN2 = 1; S.nwg = 256; S.G = G; S.c = c; S.bm = 192;
            pg8::EpiF32Sq E{WSP(bf16_t, WS_OUTF), WSP(float, WS_SQ)};
            pg8::gemm_phase<pg8::EpiF32Sq, 3, false, false>(F.lds, F.tid, S, nt, E);
        } else if (kind == K_BF) {
            pg8::Sched S{}; pg8::EpiBf16 E{}; int nt; E.mode = arg; E.wsb = F.ws; S.G = G; S.c = c; S.nM2 = 0; S.nN2 = 1; S.bm = 256;
            if (arg == pg8::M_GIN) {
                S.A = (const char*)WSP(bf16_t, WS_HB); S.B = (const char*)WSP(bf16_t, WS_WA); S.A2 = (const char*)WSP(bf16_t, WS_WV); S.B2 = (const char*)WSP(bf16_t, WS_HB);
                S.sAz = 0; S.sBz = 0; S.lda = D; S.ldb = D; S.nM = 24; S.nN = 24; S.nZ = 1; S.nM2 = 8; S.nN2 = 24; S.nwg = 576 + 192; nt = D / 64;
                E.d0 = WSP(bf16_t, WS_P); E.d1 = WSP(bf16_t, WS_VT);
            } else if (arg == pg8::M_FA) {
                S.A = (const char*)WSP(bf16_t, WS_FCT); S.B = (const char*)WSP(bf16_t, WS_HB); S.A2 = S.A; S.B2 = S.B; S.sAz = 0; S.sBz = 512 * 2;
                S.lda = 512; S.ldb = D; S.nM = 4; S.nN = 24; S.nZ = 4; S.nwg = 384; nt = 8;
                E.d0 = WSP(bf16_t, WS_YT); E.d1 = WSP(bf16_t, WS_YT) + (size_t)16 * 2048 * 512;
            } else if (arg == pg8::M_FBC) {
                S.A = (const char*)WSP(bf16_t, WS_CTC); S.B = (const char*)WSP(bf16_t, WS_YT); S.A2 = S.A; S.B2 = S.B; S.sAz = 0; S.sBz = (long)2048 * 512 * 2;
                S.lda = 512; S.ldb = 512; S.nM = 1; S.nN = 8; S.nZ = 16; S.nwg = 128; nt = 8;
                E.d0 = WSP(bf16_t, WS_FB); E.d1 = E.d0;
            } else {
                S.A = (const char*)WSP(bf16_t, WS_CTL); S.B = (const char*)(WSP(bf16_t, WS_YT) + (size_t)16 * 2048 * 512); S.A2 = S.A; S.B2 = S.B; S.sAz = 0; S.sBz = (long)2048 * 2048 * 2;
                S.lda = D; S.ldb = D; S.nM = 4; S.nN = 8; S.nZ = 2; S.nwg = 64; nt = 32; S.c = (G == 256) ? ((c + 128) & 255) : c;
                E.d0 = WSP(bf16_t, WS_FB); E.d1 = E.d0;
            }
            pg8::gemm_phase<pg8::EpiBf16, 4, GP_ALIGN, GP_SP2>(F.lds, F.tid, S, nt, E);
            if (arg == pg8::M_FA) { const int first = S.nwg % G; if (first > 0 && c >= first) convert_misc<1>(F, c - first, G - first); else if (first == 0) convert_misc<1>(F, c, G); }
            if (arg == pg8::M_GIN) {
                pg8::Sched S2{}; S2.A = (const char*)WSP(bf16_t, WS_HB); S2.B = (const char*)(WSP(bf16_t, WS_WA) + (size_t)6144 * D); S2.A2 = S2.A; S2.B2 = S2.B; S2.sAz = 512; S2.sBz = 512;
                S2.lda = D; S2.ldb = D; S2.nM = 24; S2.nN = 1; S2.nZ = 8; S2.nM2 = 0; S2.nN2 = 1; S2.nwg = 192; S2.G = G; S2.c = c; S2.bm = 256;
                pg8::EpiLrAtomic E2{WSP(float, WS_LR)};
                pg8::gemm_phase<pg8::EpiLrAtomic, 4, false, GP_SP2>(F.lds, F.tid, S2, 4, E2);
            }
            if (arg == pg8::M_FBL) { if (S.c >= S.nwg) { const int np = G - S.nwg; convert_misc<4>(F, S.c - S.nwg, np > 0 ? np : 1); } else if (G <= S.nwg) convert_misc<4>(F, c, G); }
        } else if (kind == K_G2) g2_phase(F);
        else if (kind == K_SCAN) scan_phase(F);
        else g4_phase(F);
}

#define LDP(i) ((const float*)(w_ + ldoff(tab, (i))))
#define STAGE_SETUP() \
        { int t_ = threadIdx.x; asm volatile("" : "+v"(t_)); F.tid = t_; F.lane = t_ & 63; F.wave = __builtin_amdgcn_readfirstlane(t_ >> 6); \
          size_t z_ = 0; asm volatile("" : "+s"(z_)); unsigned char* w_ = args.ws + z_; F.ws = w_; \
          const long long* tab = (const long long*)(w_ + WS_PTRTAB); \
          F.xp = LDP(0); F.xs = LDP(1); F.state = LDP(2); F.cnd = LDP(3); F.cctx = LDP(4); F.adaw = LDP(5); F.adab = LDP(6); F.npre = LDP(7); F.npost = LDP(8); \
          F.wgu = LDP(9); F.wdn = LDP(10); F.fw = LDP(11); F.gin = LDP(12); F.ggu = LDP(13); F.gbg = LDP(14); F.gnorm = LDP(15); F.gout = LDP(16); F.out = (float*)LDP(17); \
        }
__global__ void __launch_bounds__(512, 2) fwd_megakernel(Args args) {
    extern __shared__ __attribute__((aligned(16))) unsigned char lds_raw[];
    cg::grid_group grid = cg::this_grid();
    Frame F;
    F.lds = (LAS unsigned char*)lds_raw;
    const int G = gridDim.x, c = blockIdx.x;
    if (threadIdx.x < 16) ((LAS unsigned*)(F.lds + LDS_BARST))[threadIdx.x] = 0u;
    if (threadIdx.x == 0) { long long* tab = (long long*)(args.ws + WS_PTRTAB); const char* wb = (const char*)args.ws;
#pragma unroll
        for (int i = 0; i < 17; ++i) tab[i] = (long long)((const char*)args.in[i] - wb);
        tab[17] = (long long)((const char*)args.out - wb);
        __threadfence(); }
    __syncthreads();
    const XcdBarrier xbar = xcd_barrier_post((unsigned*)args.ws, (volatile LAS unsigned*)(F.lds + LDS_BARST));
#define RUN_STAGE(KIND, ARG, SYNC) do { constexpr int kind = (KIND), arg = (ARG); \
        STAGE_SETUP(); \
        stage_dispatch<kind, arg>(F, G, c); \
        if (SYNC) { if ((SYNC) == 2 && args.ws == nullptr) grid.sync(); xcd_barrier(xbar); } } while (0)
#define RUN_F32E(ARG, S, SLOT) do { \
        STAGE_SETUP(); \
        stage_dispatch<K_F32, (ARG)>(F, G, c); \
        if (G == 256) { pg8::Sched S_{}; S_.nM = 32; S_.nN = 8; S_.nZ = 1; S_.nM2 = 0; S_.nN2 = 1; S_.nwg = 256; S_.G = G; S_.c = c; S_.bm = 192; S_.lda = D; S_.ldb = D; S_.A = (const char*)F.ws; S_.B = S_.A; S_.A2 = S_.A; S_.B2 = S_.A; \
            pg8::Unit u_; (void)S_.next(0, u_); fused_elem(F, (S), (SLOT), u_.pm, u_.pn); } \
        else { xcd_barrier(xbar); STAGE_SETUP(); elem_phase(F, (S)); } \
        if ((S) < 6) xcd_barrier(xbar); } while (0)
    RUN_STAGE(K_PRO, 0, 2);
    RUN_STAGE(K_ELEM, 0, 1); RUN_STAGE(K_SWI, 0, 1); RUN_F32E(0, 1, 0);
    RUN_STAGE(K_BF, pg8::M_FA, 1); RUN_STAGE(K_BF, pg8::M_FBC, 0); RUN_STAGE(K_BF, pg8::M_FBL, 1); RUN_F32E(4, 2, 1);
    RUN_STAGE(K_SWI, 1, 1); RUN_F32E(1, 3, 2);
    RUN_STAGE(K_SWI, 2, 1); RUN_F32E(2, 4, 3);
    RUN_STAGE(K_BF, pg8::M_GIN, 1); RUN_STAGE(K_G2, 0, 1); RUN_STAGE(K_SCAN, 0, 1); RUN_STAGE(K_G4, 0, 1); RUN_F32E(5, 5, 4);
    RUN_STAGE(K_SWI, 3, 1); RUN_F32E(3, 6, 5);
#undef RUN_F32E
#undef RUN_STAGE
}

extern "C" void kernel_launch(void* const* d_in, const int* in_sizes, int n_in, void* d_out, int out_size, void* d_ws, size_t ws_size, hipStream_t stream) {
    static int grid_blocks = 0;
    if (grid_blocks == 0) {
        if (n_in != 17 || ws_size < WS_END) { fprintf(stderr, "kernel_launch: unexpected inputs (n_in %d, ws %zu)\n", n_in, ws_size); grid_blocks = -1; return; }
        int dev = 0, cus = 0, per_cu = 0;
        (void)hipGetDevice(&dev);
        (void)hipDeviceGetAttribute(&cus, hipDeviceAttributeMultiprocessorCount, dev);
        if (hipFuncSetAttribute((const void*)fwd_megakernel, hipFuncAttributeMaxDynamicSharedMemorySize, LDS_BYTES) != hipSuccess) { fprintf(stderr, "kernel_launch: hipFuncSetAttribute failed\n"); grid_blocks = -1; return; }
        if (hipOccupancyMaxActiveBlocksPerMultiprocessor(&per_cu, (const void*)fwd_megakernel, 512, LDS_BYTES) != hipSuccess || per_cu < 1) { fprintf(stderr, "kernel_launch: occupancy query failed (%d)\n", per_cu); (void)hipGetLastError(); per_cu = 1; }
        grid_blocks = cus * per_cu;
    }
    if (grid_blocks < 0) return;
    if (hipMemsetAsync(d_ws, 0, 131072, stream) != hipSuccess) { fprintf(stderr, "kernel_launch: memset of barrier words failed\n"); return; }
    Args a{};
    for (int i = 0; i < 17; ++i) a.in[i] = (const float*)d_in[i];
    a.out = (float*)d_out; a.ws = (unsigned char*)d_ws;
    void* kargs[] = {&a};
    hipError_t e = hipLaunchCooperativeKernel((const void*)fwd_megakernel, dim3(grid_blocks), dim3(512), kargs, LDS_BYTES, stream);
    if (e != hipSuccess) fprintf(stderr, "cooperative launch failed: %s (grid %d)\n", hipGetErrorString(e), grid_blocks);
}
```

```cpp
#include <hip/hip_runtime.h>
#include <hip/hip_cooperative_groups.h>
#include <cstdio>
#include <cstdint>
namespace cg = cooperative_groups;

#define LAS __attribute__((address_space(3)))
typedef unsigned short bf16_t;
typedef short bf16x8 __attribute__((ext_vector_type(8)));
typedef float f32x4 __attribute__((ext_vector_type(4)));
typedef float f32x2 __attribute__((ext_vector_type(2)));
typedef unsigned u32x4 __attribute__((ext_vector_type(4)));
typedef unsigned u32x2 __attribute__((ext_vector_type(2)));

constexpr int D = 2048, FF = 5632, NCTX = 4096, MROWS = 6144, NMOD = 9 * D;
constexpr int PLD = 6400;
constexpr float EPS = 1e-6f;
constexpr int LDS_BYTES = 157696 + 64, LDS_BARST = 157696;

constexpr size_t MiB = 1u << 20;
constexpr size_t WS_PTRTAB = 32768;
constexpr size_t WS_MOD = 1 * MiB, WS_SQ = 2 * MiB, WS_EL = 3 * MiB, WS_FCT = 4 * MiB, WS_CTC = 5 * MiB, WS_CTL = 6 * MiB;
constexpr size_t WS_LR = 11 * MiB;
constexpr size_t WS_COMB = 12 * MiB;
constexpr size_t WS_W1 = 16 * MiB, WS_W2 = 192 * MiB, WS_FW = 280 * MiB, WS_WO = 288 * MiB, WS_WA = 296 * MiB, WS_WV = 322 * MiB;
constexpr size_t WS_HB = 330 * MiB, WS_HID = 354 * MiB, WS_OUTF = 420 * MiB, WS_P = 468 * MiB, WS_VT = 543 * MiB, WS_QT = 567 * MiB, WS_KT = 591 * MiB;
constexpr size_t WS_KHT = 615 * MiB, WS_O = 639 * MiB, WS_ON = 735 * MiB, WS_YT = 759 * MiB, WS_FB = 807 * MiB, WS_END = 831 * MiB;
constexpr size_t W1_ELEMS = (size_t)11264 * 2048, W2_ELEMS = (size_t)2048 * 5632;

typedef __bf16 bf16x2_t __attribute__((ext_vector_type(2)));
__device__ __forceinline__ unsigned cvt_pk_bf16(float lo, float hi) { const bf16x2_t v = {(__bf16)lo, (__bf16)hi}; return __builtin_bit_cast(unsigned, v); }
__device__ __forceinline__ float bf2f(bf16_t b) { return __uint_as_float(((unsigned)b) << 16); }
__device__ __forceinline__ float wave_sum(float v) {
#pragma unroll
    for (int o = 1; o < 64; o <<= 1) v += __shfl_xor(v, o);
    return v;
}
__device__ __forceinline__ long long ldoff(const long long* tab, int i) {
    const unsigned long long v = (unsigned long long)__hip_atomic_load(tab + i, __ATOMIC_RELAXED, __HIP_MEMORY_SCOPE_AGENT);
    const unsigned lo = __builtin_amdgcn_readfirstlane((unsigned)v), hi = __builtin_amdgcn_readfirstlane((unsigned)(v >> 32));
    return (long long)(((unsigned long long)hi << 32) | lo);
}
__device__ __forceinline__ float silu_f(float g) { return g * __builtin_amdgcn_rcpf(1.0f + __expf(-g)); }

#ifndef GP_SP2
#define GP_SP2 true
#endif
#ifndef GP_ALIGN
#define GP_ALIGN true
#endif
namespace pg8 {
constexpr int BM = 256, BK = 64, HALF = 128, HTB = HALF * BK * 2, NXCD = 8, WGM = 4;
__device__ __forceinline__ int lds_byte(int r, int c) { const int st = (r >> 4) * 2 + (c >> 5), rr = r & 15, cc = c & 31, ob = rr * 64 + cc * 2; return st * 1024 + (ob ^ (((ob >> 9) & 1) << 5)); }
__device__ __forceinline__ void stage_rc(int b, int& R, int& C) { const int st = b / 1024, sb = b % 1024, swz = sb ^ (((sb >> 9) & 1) << 5); R = (st >> 1) * 16 + swz / 64; C = (st & 1) * 32 + (swz % 64) / 2; }
__device__ __forceinline__ int perm32(int rho) { const int n = rho >> 4, i = rho & 15; return 8 * (i >> 2) + 4 * n + (i & 3); }

struct Unit { const char* A; const char* B; int pm, pn, z; };
struct Sched {
    const char* A; const char* B; const char* A2; const char* B2;
    long sAz, sBz;
    int lda, ldb, nM, nN, nZ, nM2, nN2, nwg, G, c, bm;
    __device__ __forceinline__ bool next(int i, Unit& u) const {
        const long L = (long)i * G + c; if (L >= nwg) return false;
        int id = (int)L; { const int q = nwg / NXCD, r = nwg % NXCD, xcd = id % NXCD, off = id / NXCD; id = (xcd < r ? xcd * (q + 1) : r * (q + 1) + (xcd - r) * q) + off; }
        const int slab = nM * nN; int z = id / slab, lid = id - z * slab, tm = nM, tn = nN;
        const char* a = A + (long)z * sAz; const char* b = B + (long)z * sBz;
        if (z >= nZ) { z = nZ; lid = id - nZ * slab; tm = nM2; tn = nN2; a = A2; b = B2; }
        const int nig = WGM * tn, gid = lid / nig, fm = gid * WGM, gsz = (tm - fm) < WGM ? (tm - fm) : WGM;
        u.pm = fm + ((lid % nig) % gsz); u.pn = (lid % nig) / gsz; u.z = z;
        u.A = a + (size_t)u.pm * bm * lda * 2; u.B = b + (size_t)u.pn * BM * ldb * 2;
        return true;
    }
};

struct EpiF32Sq {
    static constexpr bool PERM = true;
    bf16_t* C; float* sq;
    __device__ __forceinline__ void operator()(const f32x4 (&acc)[2][2][3][2], const Unit& u, int wr, int wc, int fr, int fq) const {
        const int row0 = u.pm * 192 + wr * 48 + fr, col0 = u.pn * BM + wc * 32 + 8 * fq;
        const __amdgpu_buffer_rsrc_t rsrc = __builtin_amdgcn_make_buffer_rsrc(C, 0, MROWS * D * 2, 0x00020000);
#pragma unroll
        for (int ai = 0; ai < 2; ++ai)
#pragma unroll
            for (int m = 0; m < 3; ++m) {
                const int row = row0 + ai * 96 + m * 16; const unsigned roff = (unsigned)(row * D + col0) * 2u; float s = 0.f;
#pragma unroll
                for (int bj = 0; bj < 2; ++bj) { const f32x4 v0 = acc[ai][bj][m][0], v1 = acc[ai][bj][m][1];
                    s += (v0[0] * v0[0] + v0[1] * v0[1]) + (v0[2] * v0[2] + v0[3] * v0[3]) + (v1[0] * v1[0] + v1[1] * v1[1]) + (v1[2] * v1[2] + v1[3] * v1[3]);
                    u32x4 w; w.x = cvt_pk_bf16(v0[0], v0[1]); w.y = cvt_pk_bf16(v0[2], v0[3]); w.z = cvt_pk_bf16(v1[0], v1[1]); w.w = cvt_pk_bf16(v1[2], v1[3]);
                    __builtin_amdgcn_raw_buffer_store_b128(w, rsrc, roff + (unsigned)(bj * HALF * 2), 0, 16); }
                s += __shfl_xor(s, 16); s += __shfl_xor(s, 32);
                if (fq == 0) __hip_atomic_store(sq + (size_t)row * 32 + u.pn * 4 + wc, s, __ATOMIC_RELAXED, __HIP_MEMORY_SCOPE_AGENT);
            }
    }
};
template <int MT>
struct EpiSwiGLU {
    static constexpr bool PERM = true;
    bf16_t* H; int row_off, pn_off;
    __device__ __forceinline__ void operator()(const f32x4 (&acc)[2][2][MT][2], const Unit& u, int wr, int wc, int fr, int fq) const {
        const int row0 = u.pm * (64 * MT) + row_off + wr * (16 * MT) + fr, col0 = (u.pn + pn_off) * HALF + wc * 32 + 8 * fq;
        const __amdgpu_buffer_rsrc_t rsrc = __builtin_amdgcn_make_buffer_rsrc(H, 0, MROWS * FF * 2, 0x00020000);
#pragma unroll
        for (int ai = 0; ai < 2; ++ai)
#pragma unroll
            for (int m = 0; m < MT; ++m) {
                const unsigned roff = (unsigned)((row0 + ai * (32 * MT) + m * 16) * FF + col0) * 2u;
                const f32x4 g0 = acc[ai][0][m][0], g1 = acc[ai][0][m][1], u0 = acc[ai][1][m][0], u1 = acc[ai][1][m][1];
                u32x4 w;
                w.x = cvt_pk_bf16(silu_f(g0[0]) * u0[0], silu_f(g0[1]) * u0[1]); w.y = cvt_pk_bf16(silu_f(g0[2]) * u0[2], silu_f(g0[3]) * u0[3]);
                w.z = cvt_pk_bf16(silu_f(g1[0]) * u1[0], silu_f(g1[1]) * u1[1]); w.w = cvt_pk_bf16(silu_f(g1[2]) * u1[2], silu_f(g1[3]) * u1[3]);
                __builtin_amdgcn_raw_buffer_store_b128(w, rsrc, roff, 0, 16);
            }
    }
};
struct EpiLrAtomic {
    static constexpr bool PERM = false;
    float* LR;
    __device__ __forceinline__ void operator()(const f32x4 (&acc)[2][2][4][2], const Unit& u, int wr, int wc, int fr, int fq) const {
        if (wc != 0) return;
        const int row0 = u.pm * BM + wr * 64 + fr;
#pragma unroll
        for (int ai = 0; ai < 2; ++ai)
#pragma unroll
            for (int m = 0; m < 4; ++m) { float* rowp = LR + (size_t)(row0 + ai * HALF + m * 16) * 32 + 4 * fq;
#pragma unroll
                for (int n = 0; n < 2; ++n)
#pragma unroll
                    for (int j = 0; j < 4; ++j) atomicAdd(rowp + n * 16 + j, acc[ai][0][m][n][j]); }
    }
};
enum { M_GIN = 0, M_FA = 1, M_FBC = 2, M_FBL = 3 };
struct EpiBf16 {
    static constexpr bool PERM = true;
    int mode; bf16_t* d0; bf16_t* d1; unsigned char* wsb;
    __device__ __forceinline__ void operator()(const f32x4 (&acc)[2][2][4][2], const Unit& u, int wr, int wc, int fr, int fq) const {
        bf16_t* base; int ldc;
        if (mode == M_GIN) {
            if (u.z == 0) { base = d0 + (size_t)u.pm * BM * PLD + u.pn * BM; ldc = PLD; }
            else if (u.pn < 16) { base = d1 + (size_t)u.pn * (2048 * 256) + (size_t)u.pm * BM * 256; ldc = 256; }
            else { const int b = (u.pn - 16) >> 2, s0 = ((u.pn - 16) & 3) * 256; base = d1 + (size_t)16 * 2048 * 256 + (size_t)b * (2048 * 1024) + (size_t)u.pm * BM * 1024 + s0; ldc = 1024; }
        } else if (mode == M_FA) {
            const int g = u.z, chrow = g * 512 + (u.pm & 1) * 256, part = u.pm >> 1;
            if (u.pn < 16) { base = d0 + (size_t)u.pn * (2048 * 512) + (size_t)chrow * 512 + part * 256; ldc = 512; }
            else { const int b = (u.pn - 16) >> 2, s0 = ((u.pn - 16) & 3) * 256; base = d1 + (size_t)b * (2048 * 2048) + (size_t)chrow * 2048 + part * 1024 + s0; ldc = 2048; }
        } else if (mode == M_FBC) { base = d0 + (size_t)(u.z * 256) * D + u.pn * BM; ldc = D; }
        else { base = d0 + (size_t)(NCTX + u.z * 1024 + u.pm * BM) * D + u.pn * BM; ldc = D; }
        bf16_t* p0 = base + (size_t)(wr * 64 + fr) * ldc + wc * 32 + 8 * fq;
        const __amdgpu_buffer_rsrc_t rsrc = __builtin_amdgcn_make_buffer_rsrc(wsb, 0, 0x7fffffff, 0x00020000);
        const unsigned off0 = (unsigned)((const unsigned char*)p0 - wsb);
#pragma unroll
        for (int ai = 0; ai < 2; ++ai)
#pragma unroll
            for (int m = 0; m < 4; ++m) {
                const unsigned roff = off0 + (unsigned)((ai * HALF + m * 16) * ldc) * 2u;
#pragma unroll
                for (int bj = 0; bj < 2; ++bj) { const f32x4 v0 = acc[ai][bj][m][0], v1 = acc[ai][bj][m][1];
                    u32x4 w; w.x = cvt_pk_bf16(v0[0], v0[1]); w.y = cvt_pk_bf16(v0[2], v0[3]); w.z = cvt_pk_bf16(v1[0], v1[1]); w.w = cvt_pk_bf16(v1[2], v1[3]);
                    __builtin_amdgcn_raw_buffer_store_b128(w, rsrc, roff + (unsigned)(bj * HALF * 2), 0, 16); }
            }
    }
};

template <class Epi, int MT = 4, bool ALIGN_EPI = false, bool SP2 = false>
__device__ __forceinline__ void gemm_phase(LAS unsigned char* lds, const int tid, const Sched& S, const int nt, const Epi& E) {
    const int  wid = __builtin_amdgcn_readfirstlane(tid >> 6), lane = tid & 63, wr = wid >> 2, wc = wid & 3, fr = lane & 15, fq = lane >> 4;
    const int lda = S.lda, ldb = S.ldb;
    unsigned voffA[2], voffB[2];
#pragma unroll
    for (int i = 0; i < 2; ++i) { int R, C; stage_rc(tid * 16 + i * 8192, R, C); const int Rb = Epi::PERM ? ((R & ~31) + perm32(R & 31)) : R;
        const int Ra = (R >= 32 * MT) ? R - (128 - 32 * MT) : R;
        voffA[i] = (unsigned)(Ra * lda + C) * 2u; voffB[i] = (unsigned)(Rb * ldb + C) * 2u; }
    const size_t kstep = (size_t)(BK * 2);
    const size_t hstepA = (size_t)(32 * MT) * lda * 2, hstepB = (size_t)HALF * ldb * 2;
    const unsigned ldsw = (unsigned)wid * 1024u;
    const int aoff = lds_byte(wr * (16 * MT) + fr, fq * 8), boff = lds_byte(wc * 32 + fr, fq * 8);
#define PG8_SA(b, h) (((b) * 2 + (h)) * HTB)
#define PG8_SB(b, h) ((4 + (b) * 2 + (h)) * HTB)
#define PG8_STAGE(bufoff, gbase, voff) do { _Pragma("unroll") for (int _i = 0; _i < 2; ++_i) \
        __builtin_amdgcn_global_load_lds((const unsigned*)((const char*)(gbase) + (voff)[_i]), (LAS unsigned*)(lds + (bufoff) + ldsw + _i * 8192), 16, 0, 0); } while (0)
#define PG8_LDA(dst, b, h) do { _Pragma("unroll") for (int m = 0; m < MT; ++m) _Pragma("unroll") for (int k = 0; k < 2; ++k) dst[m][k] = *(const LAS bf16x8*)(lds + PG8_SA(b, h) + aoff + m * 2048 + k * 1024); } while (0)
#define PG8_LDB(dst, b, h) do { _Pragma("unroll") for (int n = 0; n < 2; ++n) _Pragma("unroll") for (int k = 0; k < 2; ++k) dst[n][k] = *(const LAS bf16x8*)(lds + PG8_SB(b, h) + boff + n * 2048 + k * 1024); } while (0)
#define PG8_MMA(ai, bj, At, Bt) do { __builtin_amdgcn_s_setprio(1); _Pragma("unroll") for (int m = 0; m < MT; ++m) _Pragma("unroll") for (int n = 0; n < 2; ++n) _Pragma("unroll") for (int k = 0; k < 2; ++k) \
        acc[ai][bj][m][n] = __builtin_amdgcn_mfma_f32_16x16x32_bf16(Bt[n][k], At[m][k], acc[ai][bj][m][n], 0, 0, 0); __builtin_amdgcn_s_setprio(0); } while (0)
#define PG8_WAIT_V(n) asm volatile("s_waitcnt vmcnt(" #n ")" ::: "memory")
#define PG8_WAIT_L(n) asm volatile("s_waitcnt lgkmcnt(" #n ")" ::: "memory")
#define PG8_BAR __builtin_amdgcn_s_barrier()
#define PG8_SCHED __builtin_amdgcn_sched_barrier(0)
    Unit cur, nxt; int ui = 0;
    if (!S.next(0, cur)) return;
    f32x4 acc[2][2][MT][2];
    float zz = 0.f; asm volatile("" : "+v"(zz));
#pragma unroll
    for (int a = 0; a < 2; ++a)
#pragma unroll
        for (int b = 0; b < 2; ++b)
#pragma unroll
            for (int m = 0; m < MT; ++m)
#pragma unroll
                for (int n = 0; n < 2; ++n) acc[a][b][m][n] = (f32x4){zz, zz, zz, zz};
    bf16x8 At[MT][2], B0[2][2], B1[2][2];
    const char* cA = cur.A; const char* cB = cur.B;
    if constexpr (SP2) {
        PG8_STAGE(PG8_SB(0, 0), cB, voffB); PG8_STAGE(PG8_SB(0, 1), cB + hstepB, voffB); PG8_STAGE(PG8_SA(0, 0), cA, voffA); PG8_STAGE(PG8_SA(0, 1), cA + hstepA, voffA);
        if (wr == 1) PG8_BAR;
        PG8_WAIT_V(2); PG8_BAR;
        PG8_STAGE(PG8_SB(1, 0), cB + kstep, voffB); PG8_STAGE(PG8_SA(1, 0), cA + kstep, voffA); PG8_STAGE(PG8_SB(1, 1), cB + hstepB + kstep, voffB);
        PG8_WAIT_V(6); PG8_BAR;
    } else {
    PG8_STAGE(PG8_SB(0, 0), cB, voffB); PG8_STAGE(PG8_SA(0, 0), cA, voffA); PG8_STAGE(PG8_SB(0, 1), cB + hstepB, voffB); PG8_STAGE(PG8_SA(0, 1), cA + hstepA, voffA);
    if (wr == 1) PG8_BAR;
    PG8_WAIT_V(4); PG8_BAR;
    PG8_STAGE(PG8_SB(1, 0), cB + kstep, voffB); PG8_STAGE(PG8_SA(1, 0), cA + kstep, voffA); PG8_STAGE(PG8_SB(1, 1), cB + hstepB + kstep, voffB);
    PG8_WAIT_V(6); PG8_BAR;
    }
    for (;;) {
        const bool has_next = S.next(ui + 1, nxt);
        const char* nA = has_next ? nxt.A : cA; const char* nB = has_next ? nxt.B : cB;
        for (int t = 0; t < nt; t += 2) {
            const bool last = (t == nt - 2);
            const char* a1 = cA + (size_t)(t + 1) * kstep;
            const char* a2 = last ? nA : cA + (size_t)(t + 2) * kstep; const char* b2 = last ? nB : cB + (size_t)(t + 2) * kstep;
            const char* a3 = a2 + kstep; const char* b3 = b2 + kstep;
            if constexpr (SP2) {
            PG8_LDB(B0, 0, 0); PG8_LDB(B1, 0, 1); PG8_SCHED; PG8_LDA(At, 0, 0); PG8_STAGE(PG8_SA(1, 1), a1 + hstepA, voffA);
            PG8_WAIT_V(8); PG8_WAIT_L(0); PG8_BAR; PG8_MMA(0, 0, At, B0); PG8_MMA(0, 1, At, B1); PG8_BAR; PG8_SCHED;
            PG8_LDA(At, 0, 1); PG8_STAGE(PG8_SB(0, 0), b2, voffB); PG8_STAGE(PG8_SB(0, 1), b2 + hstepB, voffB); PG8_STAGE(PG8_SA(0, 0), a2, voffA);
            PG8_WAIT_V(8); PG8_WAIT_L(0); PG8_BAR; PG8_MMA(1, 0, At, B0); PG8_MMA(1, 1, At, B1); PG8_BAR; PG8_SCHED;
            PG8_LDB(B0, 1, 0); PG8_LDB(B1, 1, 1); PG8_SCHED; PG8_LDA(At, 1, 0); PG8_STAGE(PG8_SA(0, 1), a2 + hstepA, voffA);
            PG8_WAIT_V(8); PG8_WAIT_L(0); PG8_BAR; PG8_MMA(0, 0, At, B0); PG8_MMA(0, 1, At, B1); PG8_BAR; PG8_SCHED;
            PG8_LDA(At, 1, 1); PG8_STAGE(PG8_SB(1, 0), b3, voffB); PG8_STAGE(PG8_SB(1, 1), b3 + hstepB, voffB); PG8_STAGE(PG8_SA(1, 0), a3, voffA);
            PG8_WAIT_V(8); PG8_WAIT_L(0); PG8_BAR; PG8_MMA(1, 0, At, B0); PG8_MMA(1, 1, At, B1); PG8_BAR; PG8_SCHED;
            } else {
            PG8_LDB(B0, 0, 0); PG8_SCHED; PG8_LDA(At, 0, 0); PG8_STAGE(PG8_SA(1, 1), a1 + hstepA, voffA);
            PG8_WAIT_L(8); PG8_BAR; PG8_WAIT_L(0); PG8_MMA(0, 0, At, B0); PG8_BAR; PG8_SCHED;
            PG8_LDB(B1, 0, 1); PG8_STAGE(PG8_SB(0, 0), b2, voffB);
            PG8_BAR; PG8_WAIT_L(0); PG8_MMA(0, 1, At, B1); PG8_BAR;
            PG8_LDA(At, 0, 1); PG8_STAGE(PG8_SA(0, 0), a2, voffA);
            PG8_BAR; PG8_WAIT_L(0); PG8_MMA(1, 0, At, B0); PG8_BAR; PG8_SCHED;
            PG8_STAGE(PG8_SB(0, 1), b2 + hstepB, voffB);
            PG8_WAIT_V(6); PG8_BAR; PG8_MMA(1, 1, At, B1); PG8_BAR;
            PG8_LDB(B0, 1, 0); PG8_SCHED; PG8_LDA(At, 1, 0); PG8_STAGE(PG8_SA(0, 1), a2 + hstepA, voffA);
            PG8_WAIT_L(8); PG8_BAR; PG8_WAIT_L(0); PG8_MMA(0, 0, At, B0); PG8_BAR; PG8_SCHED;
            PG8_LDB(B1, 1, 1); PG8_STAGE(PG8_SB(1, 0), b3, voffB);
            PG8_BAR; PG8_WAIT_L(0); PG8_MMA(0, 1, At, B1); PG8_BAR;
            PG8_LDA(At, 1, 1); PG8_STAGE(PG8_SA(1, 0), a3, voffA);
            PG8_BAR; PG8_WAIT_L(0); PG8_MMA(1, 0, At, B0); PG8_BAR; PG8_SCHED;
            PG8_STAGE(PG8_SB(1, 1), b3 + hstepB, voffB);
            PG8_WAIT_V(6); PG8_BAR; PG8_MMA(1, 1, At, B1); PG8_BAR;
            }
        }
        if constexpr (ALIGN_EPI) { if (wr == 0) PG8_BAR; }
        E(acc, cur, wr, wc, fr, fq);
        if (!has_next) break;
#pragma unroll
        for (int a = 0; a < 2; ++a)
#pragma unroll
            for (int b = 0; b < 2; ++b)
#pragma unroll
                for (int m = 0; m < MT; ++m)
#pragma unroll
                    for (int n = 0; n < 2; ++n) acc[a][b][m][n] = (f32x4){zz, zz, zz, zz};
        cur = nxt; cA = nA; cB = nB; ++ui;
        if constexpr (ALIGN_EPI) { if (wr == 1) PG8_BAR; }
    }
    PG8_WAIT_V(0);
    if constexpr (!ALIGN_EPI) { if (wr == 0) PG8_BAR; }
    PG8_BAR;
#undef PG8_SA
#undef PG8_SB
#undef PG8_STAGE
#undef PG8_LDA
#undef PG8_LDB
#undef PG8_MMA
#undef PG8_WAIT_V
#undef PG8_WAIT_L
#undef PG8_BAR
#undef PG8_SCHED
}
}


#define XB_TMO      128
#define XB_XCNT(j)  (256  + 64 * (j))
#define XB_XSUB(j)  (1280 + 64 * (j))
#define XB_XGEN(j)  (2304 + 64 * (j))
#define XB_TOP      3328
#define XB_TOPGEN   3392
#define XCD_BAR_WORDS 3456
#define XB_SPIN_CAP (1u << 18)
__device__ __forceinline__ unsigned xb_ld(unsigned* p)              { return __hip_atomic_load(p, __ATOMIC_RELAXED, __HIP_MEMORY_SCOPE_AGENT); }
__device__ __forceinline__ unsigned xb_add(unsigned* p, unsigned v) { return __hip_atomic_fetch_add(p, v, __ATOMIC_RELAXED, __HIP_MEMORY_SCOPE_AGENT); }
__device__ __forceinline__ unsigned xb_xcc_id() { return (unsigned)__builtin_amdgcn_s_getreg((3 << 11) | 20) & 0xFu; }
#define XB_SPIN(cond, bar) do { unsigned _sp = 0; while (cond) { __builtin_amdgcn_s_sleep(1); \
    if ((++_sp & 255u) == 0u) { if (xb_ld(&(bar)[XB_TMO])) break; if (_sp > XB_SPIN_CAP) { atomicAdd(&(bar)[XB_TMO], 1u); break; } } } } while (0)
struct XcdBarrier { unsigned* bar; unsigned x; volatile LAS unsigned* st; };
__device__ __forceinline__ XcdBarrier xcd_barrier_post(unsigned* bar, volatile LAS unsigned* st) {
    XcdBarrier b; b.bar = bar; b.x = xb_xcc_id(); b.st = st;
    if (threadIdx.x == 0) (void)xb_add(&bar[XB_XCNT(b.x)], 1u);
    return b;
}
__device__ __forceinline__ void xcd_barrier_complete(unsigned* bar, unsigned x, unsigned& nloc, unsigned& nx) {
    const unsigned G = gridDim.x * gridDim.y * gridDim.z;
    unsigned sum, cnt, mine, sp = 0u;
    for (;;) {
        sum = 0u; cnt = 0u; mine = 0u;
#pragma unroll
        for (unsigned j = 0; j < 16; ++j) { const unsigned c = xb_ld(&bar[XB_XCNT(j)]); sum += c; cnt += (c > 0u) ? 1u : 0u; mine = (j == x) ? c : mine; }
        if (sum == G) break;
        __builtin_amdgcn_s_sleep(1);
        if ((++sp & 255u) == 0u) { if (xb_ld(&bar[XB_TMO])) break; if (sp > XB_SPIN_CAP) { atomicAdd(&bar[XB_TMO], 1u); break; } }
    }
    nloc = mine > 0u ? mine : 1u; nx = cnt > 0u ? cnt : 1u;
}
__device__ __forceinline__ void xcd_barrier(const XcdBarrier& b) {
    asm volatile("s_waitcnt vmcnt(0)" ::: "memory");
    __syncthreads();
    if (threadIdx.x == 0) {
        unsigned* bar = b.bar;
        __builtin_amdgcn_s_waitcnt(0);
        unsigned nloc = b.st[0], nx = b.st[1];
        if (nloc == 0u) { xcd_barrier_complete(bar, b.x, nloc, nx); b.st[0] = nloc; b.st[1] = nx; }
        const unsigned old = xb_add(&bar[XB_XSUB(b.x)], 1u);
        const unsigned gen = old / nloc;
        if (old + 1u == (gen + 1u) * nloc) {
            __builtin_amdgcn_fence(__ATOMIC_RELEASE, "agent");
            asm volatile("s_waitcnt vmcnt(0)" ::: "memory");
            const unsigned og = xb_add(&bar[XB_TOP], 1u);
            const unsigned tg = og / nx;
            if (og + 1u == (tg + 1u) * nx) xb_add(&bar[XB_TOPGEN], 1u);
            else XB_SPIN(xb_ld(&bar[XB_TOPGEN]) == tg, bar);
            __builtin_amdgcn_fence(__ATOMIC_ACQUIRE, "agent");
            xb_add(&bar[XB_XGEN(b.x)], 1u);
            asm volatile("s_waitcnt vmcnt(0)" ::: "memory");
        } else {
            XB_SPIN(xb_ld(&bar[XB_XGEN(b.x)]) == gen, bar);
            __builtin_amdgcn_fence(__ATOMIC_ACQUIRE, "agent");
            asm volatile("s_waitcnt vmcnt(0)" ::: "memory");
        }
    }
    __syncthreads();
}

struct Args { const float* in[17]; float* out; unsigned char* ws; };
struct Frame {
    LAS unsigned char* lds; int tid, lane, wave;
    const float *xp, *xs, *state, *cnd, *cctx, *adaw, *adab, *npre, *npost, *wgu, *wdn, *fw, *gin, *ggu, *gbg, *gnorm, *gout;
    float* out; unsigned char* ws;
};
#define WSP(T, off) ((T*)(F.ws + (off)))

__device__ __forceinline__ void transpose_item(const float* W, int N, bf16_t* WT, int K, int dst_row0, LAS float* scr, int k0, int n0, int lane) {
    float v_[32];
#pragma unroll
    for (int i = 0; i < 32; ++i) { const int kk = 2 * i + (lane >> 5); v_[i] = __builtin_nontemporal_load(W + (size_t)(k0 + kk) * N + n0 + (lane & 31)); }
#pragma unroll
    for (int i = 0; i < 32; ++i) { const int kk = 2 * i + (lane >> 5); scr[kk * 33 + (lane & 31)] = v_[i]; }
    asm volatile("s_waitcnt lgkmcnt(0)" ::: "memory");
    const int c = lane & 7;
#pragma unroll
    for (int j = 0; j < 4; ++j) { const int n = (lane >> 3) + 8 * j; const LAS float* s = scr + (8 * c) * 33 + n;
        u32x4 o; o.x = cvt_pk_bf16(s[0 * 33], s[1 * 33]); o.y = cvt_pk_bf16(s[2 * 33], s[3 * 33]); o.z = cvt_pk_bf16(s[4 * 33], s[5 * 33]); o.w = cvt_pk_bf16(s[6 * 33], s[7 * 33]);
        *(u32x4*)(WT + (size_t)(dst_row0 + n) * K + k0 + 8 * c) = o; }
    asm volatile("s_waitcnt lgkmcnt(0)" ::: "memory");
}


struct TItem { const float* W; bf16_t* WT; int N, K, dr, k0, n0; };
__device__ __forceinline__ void ti_load(const TItem& t, int lane, float (&v)[32]) {
#pragma unroll
    for (int i = 0; i < 32; ++i) { const int kk = 2 * i + (lane >> 5); v[i] = __builtin_nontemporal_load(t.W + (size_t)(t.k0 + kk) * t.N + t.n0 + (lane & 31)); }
}
__device__ __forceinline__ void ti_store(const TItem& t, LAS float* scr, int lane, const float (&v)[32]) {
#pragma unroll
    for (int i = 0; i < 32; ++i) { const int kk = 2 * i + (lane >> 5); scr[kk * 33 + (lane & 31)] = v[i]; }
    asm volatile("s_waitcnt lgkmcnt(0)" ::: "memory");
    const int c = lane & 7;
#pragma unroll
    for (int j = 0; j < 4; ++j) { const int n = (lane >> 3) + 8 * j; const LAS float* s = scr + (8 * c) * 33 + n;
        u32x4 o; o.x = cvt_pk_bf16(s[0 * 33], s[1 * 33]); o.y = cvt_pk_bf16(s[2 * 33], s[3 * 33]); o.z = cvt_pk_bf16(s[4 * 33], s[5 * 33]); o.w = cvt_pk_bf16(s[6 * 33], s[7 * 33]);
        *(u32x4*)(t.WT + (size_t)(t.dr + n) * t.K + t.k0 + 8 * c) = o; }
    asm volatile("s_waitcnt lgkmcnt(0)" ::: "memory");
}
__device__ __forceinline__ void convert_ffn(Frame& F, int f, int part, int nparts) {
    LAS float* scr = (LAS float*)(F.lds + F.wave * 16384);
    const int gw = part * 8 + F.wave, NGW = nparts * 8, lane = F.lane;
    constexpr int I1 = 32 * 352, I2 = 88 * 64, NIT = I1 + I2;
    const float* w1 = F.wgu + (size_t)f * D * 11264; bf16_t* w1t = WSP(bf16_t, WS_W1) + (size_t)f * W1_ELEMS;
    const float* w2 = F.wdn + (size_t)f * FF * D; bf16_t* w2t = WSP(bf16_t, WS_W2) + (size_t)f * W2_ELEMS;
#define FFN_DECODE(it_, T) do { int r_ = (it_); \
        if (r_ < I1) { const int kb = r_ / 352, nb = r_ % 352, n0 = nb * 32; T.W = w1; T.WT = w1t; T.N = 11264; T.K = D; T.k0 = kb * 64; T.n0 = n0; \
            T.dr = (n0 < FF) ? ((n0 >> 7) * 256 + (n0 & 127)) : ((((n0 - FF) >> 7) * 256) + 128 + ((n0 - FF) & 127)); } \
        else { r_ -= I1; const int kb = r_ / 64, nb = r_ % 64; T.W = w2; T.WT = w2t; T.N = D; T.K = FF; T.k0 = kb * 64; T.n0 = nb * 32; T.dr = nb * 32; } } while (0)
    int it = gw; if (it >= NIT) return;
    TItem ta, tb; float va[32], vb[32];
    FFN_DECODE(it, ta); ti_load(ta, lane, va);
    for (;;) {
        int nx = it + NGW; bool has = nx < NIT;
        if (has) { FFN_DECODE(nx, tb); ti_load(tb, lane, vb); }
        ti_store(ta, scr, lane, va);
        if (!has) break;
        it = nx; nx = it + NGW; has = nx < NIT;
        if (has) { FFN_DECODE(nx, ta); ti_load(ta, lane, va); }
        ti_store(tb, scr, lane, vb);
        if (!has) break;
        it = nx;
    }
#undef FFN_DECODE
}
template <int WHAT>
__device__ __forceinline__ void convert_misc(Frame& F, int part, int nparts) {
    LAS float* scr = (LAS float*)(F.lds + F.wave * 16384);
    const int gw = part * 8 + F.wave, NGW = nparts * 8, lane = F.lane;
    constexpr int I3 = 32 * 64, I5 = 32 * 257;
    for (int it = gw; it < 2 * I3 + I5; it += NGW) {
        int r = it;
        if (r < I3) { if (WHAT & 1) { const int kb = r / 64, nb = r % 64; transpose_item(F.fw, D, WSP(bf16_t, WS_FW), D, nb * 32, scr, kb * 64, nb * 32, lane); } continue; }
        r -= I3;
        if (r < I3) { if (WHAT & 2) { const int kb = r / 64, nb = r % 64; transpose_item(F.gout, D, WSP(bf16_t, WS_WO), D, nb * 32, scr, kb * 64, nb * 32, lane); } continue; }
        r -= I3;
        if (WHAT & 4) { const int kb = r / 257, nb = r % 257, n0 = nb * 32;
          if (n0 < 4096) transpose_item(F.gin, 8224, WSP(bf16_t, WS_WA), D, n0, scr, kb * 64, n0, lane);
          else if (n0 < 6144) transpose_item(F.gin, 8224, WSP(bf16_t, WS_WV), D, n0 - 4096, scr, kb * 64, n0, lane);
          else transpose_item(F.gin, 8224, WSP(bf16_t, WS_WA), D, n0 - 2048, scr, kb * 64, n0, lane); }
    }
    const size_t gt = (size_t)part * 512 + F.tid, NT = (size_t)nparts * 512;
    if (WHAT & 4) { u32x4* wz = (u32x4*)(WSP(bf16_t, WS_WA) + (size_t)6176 * D);
        for (size_t e = gt; e < (size_t)224 * D / 8; e += NT) wz[e] = (u32x4){0u, 0u, 0u, 0u}; }
}

__device__ __forceinline__ void prologue(Frame& F) {
    const int tid = F.tid, lane = F.lane, wave = F.wave, G = gridDim.x;
    {
        LAS float* Ss = (LAS float*)F.lds;
        LAS float* Red = (LAS float*)(F.lds + 24576);
        for (int e = tid; e < 3 * D; e += 512) { const int c = e >> 11, k = e & 2047; const float v = (c == 0) ? F.cctx[k] : F.cnd[(c - 1) * D + k]; Ss[e] = v / (1.0f + __expf(-v)); }
        __syncthreads();
        float* MOD = WSP(float, WS_MOD);
        for (int it = blockIdx.x; it < 256; it += G) {
            const int l = it >> 7, col0 = (it & 127) * 144; const bool on = lane < 36;
            const float* Wp = F.adaw + (size_t)l * D * NMOD + (size_t)(wave * 256) * NMOD + col0 + 4 * (on ? lane : 0);
            f32x4 a0 = {0.f, 0.f, 0.f, 0.f}, a1 = a0, a2 = a0;
            if (on) {
                for (int kb = 0; kb < 256; kb += 16) {
                    f32x4 w[16];
#pragma unroll
                    for (int j = 0; j < 16; ++j) w[j] = __builtin_nontemporal_load((const f32x4*)(Wp + (size_t)(kb + j) * NMOD));
#pragma unroll
                    for (int j = 0; j < 16; ++j) { const int k = wave * 256 + kb + j; const float s0 = Ss[k], s1 = Ss[D + k], s2 = Ss[2 * D + k];
                        a0 += w[j] * s0; a1 += w[j] * s1; a2 += w[j] * s2; }
                }
                *(LAS f32x4*)(Red + (wave * 3 + 0) * 144 + 4 * lane) = a0; *(LAS f32x4*)(Red + (wave * 3 + 1) * 144 + 4 * lane) = a1; *(LAS f32x4*)(Red + (wave * 3 + 2) * 144 + 4 * lane) = a2;
            }
            __syncthreads();
            if (tid < 432) { const int c = tid / 144, n = tid % 144; float s = 0.f;
#pragma unroll
                for (int w8 = 0; w8 < 8; ++w8) s += Red[(w8 * 3 + c) * 144 + n];
                MOD[(size_t)(l * 3 + c) * NMOD + col0 + n] = s + F.adab[(size_t)l * NMOD + col0 + n]; }
            __syncthreads();
        }
    }
    convert_ffn(F, 0, blockIdx.x, G);
    {
        const size_t gt = (size_t)blockIdx.x * 512 + tid, NT = (size_t)G * 512;
        for (size_t e = gt; e < (size_t)1024 * 64; e += NT) { const int row = (int)(e >> 6), k0 = (int)(e & 63) * 8, n = row & 511; const bool sn = row >= 512; float v[8];
#pragma unroll
            for (int j = 0; j < 8; ++j) { const int m = (n * (k0 + j)) & 511; float s, c; sincospif((float)m * (1.0f / 256.0f), &s, &c); v[j] = (sn ? s : c) * 0.044194173824159216f; }
            u32x4 o; o.x = cvt_pk_bf16(v[0], v[1]); o.y = cvt_pk_bf16(v[2], v[3]); o.z = cvt_pk_bf16(v[4], v[5]); o.w = cvt_pk_bf16(v[6], v[7]);
            *(u32x4*)(WSP(bf16_t, WS_FCT) + (size_t)row * 512 + k0) = o; }
        for (size_t e = gt; e < (size_t)256 * 64; e += NT) { const int row = (int)(e >> 6), k0 = (int)(e & 63) * 8; float v[8];
#pragma unroll
            for (int j = 0; j < 8; ++j) { const int kk = k0 + j, s_ = kk & 255; const int m = (row * s_) & 255; float s, c; sincospif((float)m * (1.0f / 128.0f), &s, &c); v[j] = (kk >= 256 ? -s : c) * 0.0625f; }
            u32x4 o; o.x = cvt_pk_bf16(v[0], v[1]); o.y = cvt_pk_bf16(v[2], v[3]); o.z = cvt_pk_bf16(v[4], v[5]); o.w = cvt_pk_bf16(v[6], v[7]);
            *(u32x4*)(WSP(bf16_t, WS_CTC) + (size_t)row * 512 + k0) = o; }
        for (size_t e = gt; e < (size_t)1024 * 256; e += NT) { const int row = (int)(e >> 8), k0 = (int)(e & 255) * 8; float v[8];
#pragma unroll
            for (int j = 0; j < 8; ++j) { const int kk = k0 + j, s_ = kk & 1023; const int m = (row * s_) & 1023; float s, c; sincospif((float)m * (1.0f / 512.0f), &s, &c); v[j] = (kk >= 1024 ? -s : c) * 0.03125f; }
            u32x4 o; o.x = cvt_pk_bf16(v[0], v[1]); o.y = cvt_pk_bf16(v[2], v[3]); o.z = cvt_pk_bf16(v[4], v[5]); o.w = cvt_pk_bf16(v[6], v[7]);
            *(u32x4*)(WSP(bf16_t, WS_CTL) + (size_t)row * 2048 + k0) = o; }
    }
}

__device__ __forceinline__ void elem_phase(Frame& F, int s) {
    const int gw = blockIdx.x * 8 + F.wave, NGW = gridDim.x * 8, lane = F.lane;
    const float* MOD = WSP(float, WS_MOD); const float* SQ = WSP(float, WS_SQ); const bf16_t* OUTB = WSP(bf16_t, WS_OUTF); bf16_t* HB = WSP(bf16_t, WS_HB);
    float* COMB = WSP(float, WS_COMB);
    if (s == 0) {
        for (int idx = gw; idx < 54 * 8; idx += NGW) { const int t = idx >> 3, col = (idx & 7) * 256 + 4 * lane, v = t % 3, k = (t / 3) % 3, cc = (t / 9) % 3, l = t / 27;
            const float* m = MOD + (size_t)(l * 3 + cc) * NMOD; f32x4 r;
            if (v == 0) { const float w = (k == 1) ? 1.0f : 0.5f; r = *(const f32x4*)(m + (3 * k + 2) * D + col) * *(const f32x4*)(F.npost + (size_t)(l * 3 + k) * D + col) * w; }
            else if (v == 1) r = *(const f32x4*)(F.npre + (size_t)(l * 3 + k) * D + col) * (*(const f32x4*)(m + (3 * k + 1) * D + col) + 1.0f);
            else r = *(const f32x4*)(m + (3 * k) * D + col);
            *(f32x4*)(COMB + (size_t)t * D + col) = r; }
        for (int r = gw; r < MROWS; r += NGW) {
            const int cidx = r < NCTX ? 0 : 1 + ((r - NCTX) >> 10);
            const float* xin = r < NCTX ? F.xp + (size_t)r * D : F.xs + (size_t)(r - NCTX) * D;
            f32x4 x[8], g[8], a[8], b[8];
            const f32x4* gpr = (const f32x4*)F.npre; const f32x4* sh = (const f32x4*)(MOD + (size_t)cidx * NMOD); const f32x4* sc = (const f32x4*)(MOD + (size_t)cidx * NMOD + D);
#pragma unroll
            for (int j = 0; j < 8; ++j) { x[j] = ((const f32x4*)xin)[lane + 64 * j]; g[j] = gpr[lane + 64 * j]; a[j] = sh[lane + 64 * j]; b[j] = sc[lane + 64 * j]; }
            float ss = 0.f;
#pragma unroll
            for (int j = 0; j < 8; ++j) ss += (x[j][0] * x[j][0] + x[j][1] * x[j][1]) + (x[j][2] * x[j][2] + x[j][3] * x[j][3]);
            const float rr = rsqrtf(wave_sum(ss) * (1.0f / D) + EPS);
            u32x2* hb = (u32x2*)(HB + (size_t)r * D);
#pragma unroll
            for (int j = 0; j < 8; ++j) { const f32x4 h = x[j] * rr * g[j] * (b[j] + 1.0f) + a[j]; u32x2 o; o.x = cvt_pk_bf16(h[0], h[1]); o.y = cvt_pk_bf16(h[2], h[3]); hb[lane + 64 * j] = o; }
        }
        return;
    }
    const int lp = (s - 1) / 3, kp = (s - 1) % 3, l = s / 3, k = s % 3;
    for (int r = gw; r < MROWS; r += NGW) {
        const int cidx = r < NCTX ? 0 : 1 + ((r - NCTX) >> 10);
        const float* xin = (s <= 1) ? (r < NCTX ? F.xp + (size_t)r * D : F.xs + (size_t)(r - NCTX) * D) : F.out + (size_t)r * D;
        const f32x4* Gp = (const f32x4*)(COMB + (size_t)(((lp * 3 + cidx) * 3 + kp) * 3 + 0) * D);
        const f32x4* Ap = (const f32x4*)(COMB + (size_t)(((l * 3 + cidx) * 3 + k) * 3 + 1) * D);
        const f32x4* Bp = (const f32x4*)(COMB + (size_t)(((l * 3 + cidx) * 3 + k) * 3 + 2) * D);
        const u32x2* o4 = (const u32x2*)(OUTB + (size_t)r * D);
        f32x4 x[8], g[8], a[8], b[8]; u32x2 ov[8];
        const float part = lane < 32 ? SQ[(size_t)r * 32 + lane] : 0.f;
#pragma unroll
        for (int j = 0; j < 8; ++j) { x[j] = ((const f32x4*)xin)[lane + 64 * j]; ov[j] = o4[lane + 64 * j]; g[j] = Gp[lane + 64 * j]; }
        if (s < 6) {
#pragma unroll
            for (int j = 0; j < 8; ++j) { a[j] = Ap[lane + 64 * j]; b[j] = Bp[lane + 64 * j]; }
        }
        const float rs = rsqrtf(wave_sum(part) * (1.0f / D) + EPS);
#pragma unroll
        for (int j = 0; j < 8; ++j) {
            const f32x4 o = {__uint_as_float(ov[j].x << 16), __uint_as_float(ov[j].x & 0xffff0000u), __uint_as_float(ov[j].y << 16), __uint_as_float(ov[j].y & 0xffff0000u)};
            x[j] += g[j] * (o * rs); }
#pragma unroll
        for (int j = 0; j < 8; ++j) ((f32x4*)(F.out + (size_t)r * D))[lane + 64 * j] = x[j];
        if (s == 4 && lane < 32) WSP(float, WS_LR)[(size_t)r * 32 + lane] = 0.f;
        if (s < 6) {
            float ss = 0.f;
#pragma unroll
            for (int j = 0; j < 8; ++j) ss += (x[j][0] * x[j][0] + x[j][1] * x[j][1]) + (x[j][2] * x[j][2] + x[j][3] * x[j][3]);
            const float rr = rsqrtf(wave_sum(ss) * (1.0f / D) + EPS);
            u32x2* hb = (u32x2*)(HB + (size_t)r * D);
#pragma unroll
            for (int j = 0; j < 8; ++j) { const f32x4 h = x[j] * rr * a[j] + b[j]; u32x2 o; o.x = cvt_pk_bf16(h[0], h[1]); o.y = cvt_pk_bf16(h[2], h[3]); hb[lane + 64 * j] = o; }
        }
    }
}

constexpr size_t WS_PCNT = 65536;
__device__ __forceinline__ void fused_elem(Frame& F, const int s, const int slot, const int pm, const int pn) {
    const int lane = F.lane, rbase = pm * 192 + pn * 24 + F.wave * 3;
    const bf16_t* OUTB = WSP(bf16_t, WS_OUTF); const float* SQ = WSP(float, WS_SQ); bf16_t* HB = WSP(bf16_t, WS_HB); const float* COMB = WSP(float, WS_COMB);
    f32x4 x[3][8];
#pragma unroll
    for (int q = 0; q < 3; ++q) { const int r = rbase + q;
        const float* xin = (s <= 1) ? (r < NCTX ? F.xp + (size_t)r * D : F.xs + (size_t)(r - NCTX) * D) : F.out + (size_t)r * D;
#pragma unroll
        for (int j = 0; j < 8; ++j) x[q][j] = ((const f32x4*)xin)[lane + 64 * j]; }
    unsigned* cnt = (unsigned*)(F.ws + WS_PCNT + (size_t)(slot * 32 + pm) * 256);
    asm volatile("s_waitcnt vmcnt(0)" ::: "memory");
    __syncthreads();
    if (F.tid == 0) {
        __hip_atomic_fetch_add(cnt, 1u, __ATOMIC_RELAXED, __HIP_MEMORY_SCOPE_AGENT);
        unsigned sp = 0;
        while (__hip_atomic_load(cnt, __ATOMIC_RELAXED, __HIP_MEMORY_SCOPE_AGENT) < 8u) { __builtin_amdgcn_s_sleep(1); if (++sp > (1u << 22)) break; }
        __builtin_amdgcn_fence(__ATOMIC_ACQUIRE, "agent");
        asm volatile("s_waitcnt vmcnt(0)" ::: "memory");
    }
    __syncthreads();
    const int lp = (s - 1) / 3, kp = (s - 1) % 3, l = s / 3, k = s % 3;
#pragma unroll
    for (int q = 0; q < 3; ++q) { const int r = rbase + q;
        const int cidx = r < NCTX ? 0 : 1 + ((r - NCTX) >> 10);
        const f32x4* Gp = (const f32x4*)(COMB + (size_t)(((lp * 3 + cidx) * 3 + kp) * 3 + 0) * D);
        const f32x4* Ap = (const f32x4*)(COMB + (size_t)(((l * 3 + cidx) * 3 + k) * 3 + 1) * D);
        const f32x4* Bp = (const f32x4*)(COMB + (size_t)(((l * 3 + cidx) * 3 + k) * 3 + 2) * D);
        const u32x2* o4 = (const u32x2*)(OUTB + (size_t)r * D);
        f32x4 g[8], a[8], b[8]; u32x2 ov[8];
        const float part = lane < 32 ? __hip_atomic_load(SQ + (size_t)r * 32 + lane, __ATOMIC_RELAXED, __HIP_MEMORY_SCOPE_AGENT) : 0.f;
#pragma unroll
        for (int j = 0; j < 8; ++j) { ov[j] = o4[lane + 64 * j]; g[j] = Gp[lane + 64 * j]; }
        if (s < 6) {
#pragma unroll
            for (int j = 0; j < 8; ++j) { a[j] = Ap[lane + 64 * j]; b[j] = Bp[lane + 64 * j]; }
        }
        const float rs = rsqrtf(wave_sum(part) * (1.0f / D) + EPS);
#pragma unroll
        for (int j = 0; j < 8; ++j) {
            const f32x4 o = {__uint_as_float(ov[j].x << 16), __uint_as_float(ov[j].x & 0xffff0000u), __uint_as_float(ov[j].y << 16), __uint_as_float(ov[j].y & 0xffff0000u)};
            x[q][j] += g[j] * (o * rs); }
#pragma unroll
        for (int j = 0; j < 8; ++j) ((f32x4*)(F.out + (size_t)r * D))[lane + 64 * j] = x[q][j];
        if (s == 4 && lane < 32) WSP(float, WS_LR)[(size_t)r * 32 + lane] = 0.f;
        if (s < 6) {
            float ss = 0.f;
#pragma unroll
            for (int j = 0; j < 8; ++j) ss += (x[q][j][0] * x[q][j][0] + x[q][j][1] * x[q][j][1]) + (x[q][j][2] * x[q][j][2] + x[q][j][3] * x[q][j][3]);
            const float rr = rsqrtf(wave_sum(ss) * (1.0f / D) + EPS);
            u32x2* hb = (u32x2*)(HB + (size_t)r * D);
#pragma unroll
            for (int j = 0; j < 8; ++j) { const f32x4 h = x[q][j] * rr * a[j] + b[j]; u32x2 o; o.x = cvt_pk_bf16(h[0], h[1]); o.y = cvt_pk_bf16(h[2], h[3]); hb[lane + 64 * j] = o; }
        }
    }
}

__device__ __forceinline__ void g2_phase(Frame& F) {
    LAS float* Gs = (LAS float*)F.lds;
    LAS float* Tot = (LAS float*)(F.lds + 65536);
    LAS float* LRs = (LAS float*)(F.lds + 65536 + 2048);
    LAS bf16_t* KHs = (LAS bf16_t*)(F.lds + 65536 + 2048 + 4096);
    const int tid = F.tid, ch = tid & 255, th = __builtin_amdgcn_readfirstlane(tid >> 8);
    const bf16_t* P = WSP(bf16_t, WS_P); bf16_t* QT = WSP(bf16_t, WS_QT); bf16_t* KT = WSP(bf16_t, WS_KT); bf16_t* KHT = WSP(bf16_t, WS_KHT); float* EL = WSP(float, WS_EL);
    for (int it = blockIdx.x; it < 768; it += gridDim.x) {
        const int cgk = it >> 3, d = (it >> 2) & 1, h = it & 3;
        int b, c, row0, lat;
        if (cgk < 64) { b = cgk >> 2; c = cgk & 3; row0 = b * 256 + c * 64; lat = 0; } else { const int cl = cgk - 64; b = cl >> 4; c = cl & 15; row0 = NCTX + b * 1024 + c * 64; lat = 1; }
        const int chd = h * 256 + ch;
        for (int e = tid; e < 1024; e += 512) { const int i = e >> 4, rk = e & 15; LRs[e] = WSP(float, WS_LR)[(size_t)(row0 + i) * 32 + d * 16 + rk]; }
        float wg[16];
#pragma unroll
        for (int rk = 0; rk < 16; ++rk) wg[rk] = F.ggu[(size_t)(d * 16 + rk) * 1024 + chd];
        const float bg = F.gbg[d * 1024 + chd];
        __syncthreads();
        float run = 0.f;
        for (int ii = 0; ii < 32; ++ii) {
            const int i = d == 0 ? th * 32 + ii : th * 32 + 31 - ii;
            float xg = bg;
#pragma unroll
            for (int q4 = 0; q4 < 4; ++q4) { const f32x4 l4 = *(const LAS f32x4*)(LRs + i * 16 + q4 * 4);
                xg += l4[0] * wg[q4 * 4] + l4[1] * wg[q4 * 4 + 1] + l4[2] * wg[q4 * 4 + 2] + l4[3] * wg[q4 * 4 + 3]; }
            const float g = (fminf(xg, 0.f) - __logf(1.0f + __expf(-fabsf(xg)))) * 0.0625f;
            run += g; Gs[i * 256 + ch] = run;
        }
        Tot[th * 256 + ch] = run;
        __syncthreads();
        const float tot0 = Tot[ch], tot1 = Tot[256 + ch], total = tot0 + tot1;
        const float fix = (d == 0) ? (th == 1 ? tot0 : 0.f) : (th == 0 ? tot1 : 0.f);
        const int p = ch >> 1;
        const float inv = exp2f(-(float)(p & 63) * (13.287712379549449f / 64.0f));
        const int qcol = (d ? 2048 : 0) + chd, kcol = (d ? 3072 : 1024) + chd;
        const float elc = __expf(total);
        bf16_t qraw[32], kraw[32];
#pragma unroll
        for (int ii = 0; ii < 32; ++ii) { const size_t row = (size_t)(row0 + th * 32 + ii); qraw[ii] = P[row * PLD + qcol]; kraw[ii] = P[row * PLD + kcol]; }
#pragma unroll
        for (int ii = 0; ii < 32; ++ii) {
            const int i = th * 32 + ii; const size_t row = (size_t)(row0 + i);
            const float bb = Gs[i * 256 + ch] + fix;
            float qv = bf2f(qraw[ii]), kv = bf2f(kraw[ii]);
            if (lat) {
                const float ang = (float)(p < 64 ? c : i) * inv; const float sn = __sinf(ang), cs = __cosf(ang);
                const float qo = __shfl_xor(qv, 1), ko = __shfl_xor(kv, 1);
                if (ch & 1) { qv = qo * sn + qv * cs; kv = ko * sn + kv * cs; } else { qv = qv * cs - qo * sn; kv = kv * cs - ko * sn; }
            }
            const float qt = qv * 0.0625f * __expf(bb), kt = kv * __expf(-bb), kh = kt * elc;
            QT[((size_t)d * MROWS + row) * 1024 + chd] = (bf16_t)(cvt_pk_bf16(qt, 0.f) & 0xffffu);
            KT[((size_t)d * MROWS + row) * 1024 + chd] = (bf16_t)(cvt_pk_bf16(kt, 0.f) & 0xffffu);
            KHs[ch * 72 + i] = (bf16_t)(cvt_pk_bf16(kh, 0.f) & 0xffffu);
        }
        if (th == 0) EL[(size_t)(d * 96 + cgk) * 1024 + chd] = elc;
        __syncthreads();
        { const int rch = tid >> 1, hf = tid & 1;
          bf16_t* dst = (lat ? KHT + (size_t)2 * 16 * 1024 * 256 + ((size_t)((d * 2 + b) * 1024 + h * 256 + rch)) * 1024 : KHT + ((size_t)((d * 16 + b) * 1024 + h * 256 + rch)) * 256) + c * 64 + hf * 32;
          const LAS u32x4* src = (const LAS u32x4*)(KHs + rch * 72 + hf * 32);
#pragma unroll
          for (int j = 0; j < 4; ++j) ((u32x4*)dst)[j] = src[j]; }
        __syncthreads();
    }
}

constexpr int SC_QS = 0, SC_KS = 33792, SC_STS = 67584, SC_KHS = 101376, SC_VS = 138240, SC_PS = 147456, SC_ELS = 156672;
__device__ __forceinline__ int scan_item(int c, int G, int k) {
    if (G == 256) { const int x = c & 7, y = c >> 3, vs = y & 7;
        if (y < 16) { if (k == 0) return ((x + 8 * (y >> 3)) << 3) | vs; if (k < 3) return 128 + (((x + 8 * ((y >> 3) * 2 + (k - 1))) << 3) | vs); return -1; }
        return k < 6 ? 128 + (((32 + x + 8 * (((y - 16) >> 3) * 6 + k)) << 3) | vs) : -1; }
    const int id = k * G + c; return id < 1152 ? id : -1;
}
__device__ __forceinline__ void scan_phase(Frame& F) {
    const int tid = F.tid, lane = F.lane, w = F.wave, fr = lane & 15, fq = lane >> 4;
    LAS unsigned char* lds = F.lds;
    const bf16_t* QT = WSP(bf16_t, WS_QT); const bf16_t* KT = WSP(bf16_t, WS_KT); const bf16_t* KHT = WSP(bf16_t, WS_KHT); const bf16_t* VT = WSP(bf16_t, WS_VT);
    const float* EL = WSP(float, WS_EL); bf16_t* O = WSP(bf16_t, WS_O);
    for (int kk_ = 0;; ++kk_) {
        const int id = scan_item(blockIdx.x, gridDim.x, kk_); if (id < 0) break;
        const int lat = id < 128, ii = lat ? id : id - 128, vs = ii & 7, d = (ii >> 3) & 1, h = (ii >> 4) & 3, b = ii >> 6;
        const int T = lat ? 1024 : 256, nch = T >> 6, rowb = lat ? NCTX + b * 1024 : b * 256;
        const bf16_t* Qp = QT + ((size_t)d * MROWS + rowb) * 1024 + h * 256;
        const bf16_t* Kp = KT + ((size_t)d * MROWS + rowb) * 1024 + h * 256;
        const bf16_t* KHp = lat ? KHT + (size_t)2 * 16 * 1024 * 256 + ((size_t)((d * 2 + b) * 1024 + h * 256)) * 1024 : KHT + ((size_t)((d * 16 + b) * 1024 + h * 256)) * 256;
        const bf16_t* Vp = lat ? VT + (size_t)16 * 2048 * 256 + ((size_t)(b * 2048 + h * 512 + vs * 64)) * 1024 : VT + ((size_t)(b * 2048 + h * 512 + vs * 64)) * 256;
        const float* ELp = EL + (size_t)(d * 96 + (lat ? 64 + b * 16 : b * 4)) * 1024 + h * 256;
        bf16_t* Op = O + ((size_t)d * MROWS + rowb) * D + h * 512 + vs * 64;
        f32x4 acc[2][4];
        float zz = 0.f; asm volatile("" : "+v"(zz));
        if (lat) { const float* S0 = F.state + ((size_t)((b * 2 + d) * 4 + h)) * 256 * 512 + vs * 64;
            int sb = (w * 32 + 4 * fq) * 512 + fr; asm volatile("" : "+v"(sb));
#pragma unroll
            for (int ct = 0; ct < 2; ++ct)
#pragma unroll
                for (int vt = 0; vt < 4; ++vt)
#pragma unroll
                    for (int jj = 0; jj < 4; ++jj) acc[ct][vt][jj] = S0[sb + (ct * 16 + jj) * 512 + vt * 16]; }
        else {
#pragma unroll
            for (int ct = 0; ct < 2; ++ct)
#pragma unroll
                for (int vt = 0; vt < 4; ++vt) acc[ct][vt] = (f32x4){zz, zz, zz, zz}; }
#define SC_WRITE_STS() do { _Pragma("unroll") for (int ct = 0; ct < 2; ++ct) _Pragma("unroll") for (int vt = 0; vt < 4; ++vt) { u32x2 o_; o_.x = cvt_pk_bf16(acc[ct][vt][0], acc[ct][vt][1]); o_.y = cvt_pk_bf16(acc[ct][vt][2], acc[ct][vt][3]); \
            *(LAS u32x2*)(lds + SC_STS + (vt * 16 + fr) * 528 + (w * 32 + ct * 16 + 4 * fq) * 2) = o_; } } while (0)
        SC_WRITE_STS();
        u32x4 pq[4], pk[4], ph[4], pv; f32x4 pe = {zz, zz, zz, zz};
#define SC_LOAD(cc) do { const int c_ = (cc); \
            _Pragma("unroll") for (int q = 0; q < 4; ++q) { const int e = tid + 512 * q, row = e >> 5, ck = e & 31; \
                pq[q] = *(const u32x4*)(Qp + (size_t)(c_ * 64 + row) * 1024 + ck * 8); pk[q] = *(const u32x4*)(Kp + (size_t)(c_ * 64 + row) * 1024 + ck * 8); } \
            _Pragma("unroll") for (int q = 0; q < 4; ++q) { const int e = tid + 512 * q, row = e >> 3, ck = e & 7; ph[q] = *(const u32x4*)(KHp + (size_t)row * T + c_ * 64 + ck * 8); } \
            { const int row = tid >> 3, ck = tid & 7; pv = *(const u32x4*)(Vp + (size_t)row * T + c_ * 64 + ck * 8); } \
            if (tid < 64) pe = *(const f32x4*)(ELp + (size_t)c_ * 1024 + tid * 4); } while (0)
#define SC_STORE() do { \
            _Pragma("unroll") for (int q = 0; q < 4; ++q) { const int e = tid + 512 * q, row = e >> 5, ck = e & 31; \
                *(LAS u32x4*)(lds + SC_QS + row * 528 + ck * 16) = pq[q]; *(LAS u32x4*)(lds + SC_KS + row * 528 + ck * 16) = pk[q]; } \
            _Pragma("unroll") for (int q = 0; q < 4; ++q) { const int e = tid + 512 * q, row = e >> 3, ck = e & 7; *(LAS u32x4*)(lds + SC_KHS + row * 144 + ck * 16) = ph[q]; } \
            { const int row = tid >> 3, ck = tid & 7; *(LAS u32x4*)(lds + SC_VS + row * 144 + ck * 16) = pv; } \
            if (tid < 64) *(LAS f32x4*)(lds + SC_ELS + tid * 16) = pe; } while (0)
        SC_LOAD(d == 0 ? 0 : nch - 1);
        const int itile = w >> 1, t2 = (w & 1) * 2;
        for (int s = 0; s < nch; ++s) {
            const int c = d == 0 ? s : nch - 1 - s;
            SC_STORE();
            __syncthreads();
            if (s + 1 < nch) SC_LOAD(d == 0 ? s + 1 : nch - 2 - s);
#define SC_LD8(dst, off) do { _Pragma("unroll") for (int kk = 0; kk < 8; ++kk) dst[kk] = *(const LAS bf16x8*)(lds + (off) + kk * 64); } while (0)
#define SC_MM8(accv, af, bf_) do { f32x4 acc2_ = {zz, zz, zz, zz}; _Pragma("unroll") for (int kk = 0; kk < 4; ++kk) { accv = __builtin_amdgcn_mfma_f32_16x16x32_bf16(af[kk], bf_[kk], accv, 0, 0, 0); \
        acc2_ = __builtin_amdgcn_mfma_f32_16x16x32_bf16(af[kk + 4], bf_[kk + 4], acc2_, 0, 0, 0); } accv += acc2_; } while (0)
#define SC_KEEP8(x) asm volatile("" :: "v"(x[0]), "v"(x[1]), "v"(x[2]), "v"(x[3]), "v"(x[4]), "v"(x[5]), "v"(x[6]), "v"(x[7]))
            bf16x8 qf[8], fa[8];
            const int qoff = SC_QS + (itile * 16 + fr) * 528 + fq * 16;
            const int jt0 = t2, jt1 = t2 + 1;
            const bool live0 = d == 0 ? (jt0 <= itile) : (jt0 >= itile), live1 = d == 0 ? (jt1 <= itile) : (jt1 >= itile);
            f32x4 sc0 = {zz, zz, zz, zz}, sc1 = {zz, zz, zz, zz};
            f32x4 oa[2]; oa[0] = (f32x4){zz, zz, zz, zz}; oa[1] = (f32x4){zz, zz, zz, zz};
            SC_LD8(qf, qoff);
            if (live0) { SC_LD8(fa, SC_KS + (jt0 * 16 + fr) * 528 + fq * 16); __builtin_amdgcn_sched_barrier(0); SC_MM8(sc0, fa, qf); SC_KEEP8(fa); __builtin_amdgcn_sched_barrier(0); }
            if (live1) { SC_LD8(fa, SC_KS + (jt1 * 16 + fr) * 528 + fq * 16); __builtin_amdgcn_sched_barrier(0); SC_MM8(sc1, fa, qf); SC_KEEP8(fa); __builtin_amdgcn_sched_barrier(0); }
            SC_LD8(fa, SC_STS + ((t2 + 0) * 16 + fr) * 528 + fq * 16); __builtin_amdgcn_sched_barrier(0); SC_MM8(oa[0], fa, qf); SC_KEEP8(fa); __builtin_amdgcn_sched_barrier(0);
            SC_LD8(fa, SC_STS + ((t2 + 1) * 16 + fr) * 528 + fq * 16); __builtin_amdgcn_sched_barrier(0); SC_MM8(oa[1], fa, qf); SC_KEEP8(fa); SC_KEEP8(qf); __builtin_amdgcn_sched_barrier(0);
            { const int iabs = itile * 16 + fr;
#pragma unroll
              for (int jj = 0; jj < 4; ++jj) { const int j0 = jt0 * 16 + 4 * fq + jj, j1 = jt1 * 16 + 4 * fq + jj;
                  const bool ok0 = live0 && (d == 0 ? (j0 <= iabs) : (j0 >= iabs)), ok1 = live1 && (d == 0 ? (j1 <= iabs) : (j1 >= iabs));
                  sc0[jj] = ok0 ? sc0[jj] : 0.f; sc1[jj] = ok1 ? sc1[jj] : 0.f; }
              u32x2 o0, o1; o0.x = cvt_pk_bf16(sc0[0], sc0[1]); o0.y = cvt_pk_bf16(sc0[2], sc0[3]); o1.x = cvt_pk_bf16(sc1[0], sc1[1]); o1.y = cvt_pk_bf16(sc1[2], sc1[3]);
              *(LAS u32x2*)(lds + SC_PS + (itile * 16 + fr) * 144 + (jt0 * 16 + 4 * fq) * 2) = o0;
              *(LAS u32x2*)(lds + SC_PS + (itile * 16 + fr) * 144 + (jt1 * 16 + 4 * fq) * 2) = o1; }
            __syncthreads();
            bf16x8 pf[2], va[2][2];
#pragma unroll
            for (int kk = 0; kk < 2; ++kk) pf[kk] = *(const LAS bf16x8*)(lds + SC_PS + (itile * 16 + fr) * 144 + kk * 64 + fq * 16);
#pragma unroll
            for (int v2 = 0; v2 < 2; ++v2)
#pragma unroll
                for (int kk = 0; kk < 2; ++kk) va[v2][kk] = *(const LAS bf16x8*)(lds + SC_VS + ((t2 + v2) * 16 + fr) * 144 + kk * 64 + fq * 16);
            __builtin_amdgcn_sched_barrier(0);
#pragma unroll
            for (int v2 = 0; v2 < 2; ++v2) { const int vt = t2 + v2;
#pragma unroll
                for (int kk = 0; kk < 2; ++kk) oa[v2] = __builtin_amdgcn_mfma_f32_16x16x32_bf16(va[v2][kk], pf[kk], oa[v2], 0, 0, 0);
                { u32x2 ob_; ob_.x = cvt_pk_bf16(oa[v2][0], oa[v2][1]); ob_.y = cvt_pk_bf16(oa[v2][2], oa[v2][3]); *(u32x2*)(Op + (size_t)(c * 64 + itile * 16 + fr) * D + vt * 16 + 4 * fq) = ob_; } }
            __builtin_amdgcn_sched_barrier(0);
            bf16x8 kf[2][2], vb[4][2]; f32x4 el4[2];
#pragma unroll
            for (int ct = 0; ct < 2; ++ct) { el4[ct] = *(const LAS f32x4*)(lds + SC_ELS + (w * 32 + ct * 16 + 4 * fq) * 4);
#pragma unroll
                for (int kk = 0; kk < 2; ++kk) kf[ct][kk] = *(const LAS bf16x8*)(lds + SC_KHS + (w * 32 + ct * 16 + fr) * 144 + kk * 64 + fq * 16); }
#pragma unroll
            for (int vt = 0; vt < 4; ++vt)
#pragma unroll
                for (int kk = 0; kk < 2; ++kk) vb[vt][kk] = *(const LAS bf16x8*)(lds + SC_VS + (vt * 16 + fr) * 144 + kk * 64 + fq * 16);
            __builtin_amdgcn_sched_barrier(0);
#pragma unroll
            for (int ct = 0; ct < 2; ++ct)
#pragma unroll
                for (int vt = 0; vt < 4; ++vt) { acc[ct][vt] = acc[ct][vt] * el4[ct];
#pragma unroll
                    for (int kk = 0; kk < 2; ++kk) acc[ct][vt] = __builtin_amdgcn_mfma_f32_16x16x32_bf16(kf[ct][kk], vb[vt][kk], acc[ct][vt], 0, 0, 0); }
#undef SC_LD8
#undef SC_MM8
#undef SC_KEEP8
            SC_WRITE_STS();
            __syncthreads();
        }
        if (!lat) { float* So = F.out + (size_t)MROWS * D + ((size_t)((b * 2 + d) * 4 + h)) * 256 * 512 + vs * 64;
            int sb = (w * 32 + 4 * fq) * 512 + fr; asm volatile("" : "+v"(sb));
#pragma unroll
            for (int ct = 0; ct < 2; ++ct)
#pragma unroll
                for (int vt = 0; vt < 4; ++vt)
#pragma unroll
                    for (int jj = 0; jj < 4; ++jj) So[sb + (ct * 16 + jj) * 512 + vt * 16] = acc[ct][vt][jj]; }
#undef SC_WRITE_STS
#undef SC_LOAD
#undef SC_STORE
    }
}

__device__ __forceinline__ void g4_phase(Frame& F) {
    const int gw = blockIdx.x * 8 + F.wave, NGW = gridDim.x * 8, lane = F.lane;
    const bf16_t* O = WSP(bf16_t, WS_O); const bf16_t* P = WSP(bf16_t, WS_P); bf16_t* ON = WSP(bf16_t, WS_ON);
    for (int r = gw; r < MROWS; r += NGW) {
        const u32x2* o0 = (const u32x2*)(O + (size_t)r * D); const u32x2* o1 = (const u32x2*)(O + ((size_t)MROWS + r) * D);
        const u32x2* rg = (const u32x2*)(P + (size_t)r * PLD + 4096);
        f32x4 o[8]; u32x2 oa_[8], ob_[8], rv_[8]; const f32x4 gn0 = ((const f32x4*)F.gnorm)[lane], gn1 = ((const f32x4*)F.gnorm)[lane + 64];
#pragma unroll
        for (int j = 0; j < 8; ++j) { oa_[j] = o0[lane + 64 * j]; ob_[j] = o1[lane + 64 * j]; rv_[j] = rg[lane + 64 * j]; }
#pragma unroll
        for (int j = 0; j < 8; ++j) { o[j][0] = __uint_as_float(oa_[j].x << 16) + __uint_as_float(ob_[j].x << 16); o[j][1] = __uint_as_float(oa_[j].x & 0xffff0000u) + __uint_as_float(ob_[j].x & 0xffff0000u);
            o[j][2] = __uint_as_float(oa_[j].y << 16) + __uint_as_float(ob_[j].y << 16); o[j][3] = __uint_as_float(oa_[j].y & 0xffff0000u) + __uint_as_float(ob_[j].y & 0xffff0000u); }
        float rr[4];
#pragma unroll
        for (int hh = 0; hh < 4; ++hh) { float s = 0.f;
#pragma unroll
            for (int j = 2 * hh; j < 2 * hh + 2; ++j) s += (o[j][0] * o[j][0] + o[j][1] * o[j][1]) + (o[j][2] * o[j][2] + o[j][3] * o[j][3]);
            rr[hh] = rsqrtf(wave_sum(s) * (1.0f / 512.0f) + EPS); }
        u32x2* on = (u32x2*)(ON + (size_t)r * D);
#pragma unroll
        for (int j = 0; j < 8; ++j) { const f32x4 gn = (j & 1) ? gn1 : gn0; const u32x2 rv = rv_[j];
            const float r0 = __uint_as_float(rv.x << 16), r1 = __uint_as_float(rv.x & 0xffff0000u), r2 = __uint_as_float(rv.y << 16), r3 = __uint_as_float(rv.y & 0xffff0000u);
            const f32x4 v = o[j] * rr[j >> 1] * gn;
            u32x2 w_; w_.x = cvt_pk_bf16(v[0] * silu_f(r0), v[1] * silu_f(r1)); w_.y = cvt_pk_bf16(v[2] * silu_f(r2), v[3] * silu_f(r3)); on[lane + 64 * j] = w_; }
    }
}

enum { K_PRO = 0, K_ELEM, K_SWI, K_F32, K_BF, K_G2, K_SCAN, K_G4 };

template <int kind, int arg>
__device__ __forceinline__ void stage_dispatch(Frame& F, const int G, const int c) {
        if (kind == K_PRO) prologue(F);
        else if (kind == K_ELEM) elem_phase(F, arg);
        else if (kind == K_SWI) {
            pg8::Sched S{}; S.A = (const char*)WSP(bf16_t, WS_HB); S.B = (const char*)(WSP(bf16_t, WS_W1) + (size_t)arg * W1_ELEMS); S.A2 = S.A; S.B2 = S.B; S.sAz = 0; S.sBz = 0;
            S.lda = D; S.ldb = D; S.nM = 24; S.nN = 44; S.nZ = 1; S.nM2 = 0; S.nN2 = 1; S.nwg = 24 * 44; S.G = G; S.c = c; S.bm = 256;
            pg8::EpiSwiGLU<4> E{WSP(bf16_t, WS_HID), 0, 0};
            if (G == 256) {
                S.nwg = 1024;
                pg8::gemm_phase<pg8::EpiSwiGLU<4>, 4, GP_ALIGN, GP_SP2>(F.lds, F.tid, S, D / 64, E);
                pg8::Sched S2 = S; S2.A = S.A + (size_t)5120 * D * 2; S2.B = S.B + (size_t)36 * 256 * D * 2; S2.A2 = S2.A; S2.B2 = S2.B; S2.nM = 8; S2.nN = 8; S2.nwg = 64; S2.bm = 128;
                pg8::EpiSwiGLU<2> E2{WSP(bf16_t, WS_HID), 5120, 36};
                pg8::gemm_phase<pg8::EpiSwiGLU<2>, 2, false, GP_SP2>(F.lds, F.tid, S2, D / 64, E2);
            } else
            pg8::gemm_phase<pg8::EpiSwiGLU<4>, 4, GP_ALIGN, GP_SP2>(F.lds, F.tid, S, D / 64, E);
            if (arg < 3) { const int first = (G == 256) ? 64 : S.nwg % G; if (c >= first) { convert_ffn(F, arg + 1, c - first, G - first); if (arg == 1) convert_misc<2>(F, c - first, G - first); } }
        } else if (kind == K_F32) {
            pg8::Sched S{}; int nt;
            if (arg < 4) { S.A = (const char*)WSP(bf16_t, WS_HID); S.B = (const char*)(WSP(bf16_t, WS_W2) + (size_t)arg * W2_ELEMS); S.lda = FF; S.ldb = FF; nt = FF / 64; }
            else if (arg == 4) { S.A = (const char*)WSP(bf16_t, WS_FB); S.B = (const char*)WSP(bf16_t, WS_FW); S.lda = D; S.ldb = D; nt = D / 64; }
            else { S.A = (const char*)WSP(bf16_t, WS_ON); S.B = (const char*)WSP(bf16_t, WS_WO); S.lda = D; S.ldb = D; nt = D / 64; }
            S.A2 = S.A; S.B2 = S.B; S.sAz = 0; S.sBz = 0; S.nM = 32; S.nN = 8; S.nZ = 1; S.nM2 = 0; S.nN2 = 1; S.nwg = 256; S.G = G; S.c = c; S.bm = 192;
            pg8::EpiF32Sq E{WSP(bf16_t, WS_OUTF), WSP(float, WS_SQ)};
            pg8::gemm_phase<pg8::EpiF32Sq, 3, false, false>(F.lds, F.tid, S, nt, E);
        } else if (kind == K_BF) {
            pg8::Sched S{}; pg8::EpiBf16 E{}; int nt; E.mode = arg; E.wsb = F.ws; S.G = G; S.c = c; S.nM2 = 0; S.nN2 = 1; S.bm = 256;
            if (arg == pg8::M_GIN) {
                S.A = (const char*)WSP(bf16_t, WS_HB); S.B = (const char*)WSP(bf16_t, WS_WA); S.A2 = (const char*)WSP(bf16_t, WS_WV); S.B2 = (const char*)WSP(bf16_t, WS_HB);
                S.sAz = 0; S.sBz = 0; S.lda = D; S.ldb = D; S.nM = 24; S.nN = 24; S.nZ = 1; S.nM2 = 8; S.nN2 = 24; S.nwg = 576 + 192; nt = D / 64;
                E.d0 = WSP(bf16_t, WS_P); E.d1 = WSP(bf16_t, WS_VT);
            } else if (arg == pg8::M_FA) {
                S.A = (const char*)WSP(bf16_t, WS_FCT); S.B = (const char*)WSP(bf16_t, WS_HB); S.A2 = S.A; S.B2 = S.B; S.sAz = 0; S.sBz = 512 * 2;
                S.lda = 512; S.ldb = D; S.nM = 4; S.nN = 24; S.nZ = 4; S.nwg = 384; nt = 8;
                E.d0 = WSP(bf16_t, WS_YT); E.d1 = WSP(bf16_t, WS_YT) + (size_t)16 * 2048 * 512;
            } else if (arg == pg8::M_FBC) {
                S.A = (const char*)WSP(bf16_t, WS_CTC); S.B = (const char*)WSP(bf16_t, WS_YT); S.A2 = S.A; S.B2 = S.B; S.sAz = 0; S.sBz = (long)2048 * 512 * 2;
                S.lda = 512; S.ldb = 512; S.nM = 1; S.nN = 8; S.nZ = 16; S.nwg = 128; nt = 8;
                E.d0 = WSP(bf16_t, WS_FB); E.d1 = E.d0;
            } else {
                S.A = (const char*)WSP(bf16_t, WS_CTL); S.B = (const char*)(WSP(bf16_t, WS_YT) + (size_t)16 * 2048 * 512); S.A2 = S.A; S.B2 = S.B; S.sAz = 0; S.sBz = (long)2048 * 2048 * 2;
                S.lda = D; S.ldb = D; S.nM = 4; S.nN = 8; S.nZ = 2; S.nwg = 64; nt = 32; S.c = (G == 256) ? ((c + 128) & 255) : c;
                E.d0 = WSP(bf16_t, WS_FB); E.d1 = E.d0;
            }
            pg8::gemm_phase<pg8::EpiBf16, 4, GP_ALIGN, GP_SP2>(F.lds, F.tid, S, nt, E);
            if (arg == pg8::M_FA) { const int first = S.nwg % G; if (first > 0 && c >= first) convert_misc<1>(F, c - first, G - first); else if (first == 0) convert_misc<1>(F, c, G); }
            if (arg == pg8::M_GIN) {
                pg8::Sched S2{}; S2.A = (const char*)WSP(bf16_t, WS_HB); S2.B = (const char*)(WSP(bf16_t, WS_WA) + (size_t)6144 * D); S2.A2 = S2.A; S2.B2 = S2.B; S2.sAz = 512; S2.sBz = 512;
                S2.lda = D; S2.ldb = D; S2.nM = 24; S2.nN = 1; S2.nZ = 8; S2.nM2 = 0; S2.nN2 = 1; S2.nwg = 192; S2.G = G; S2.c = c; S2.bm = 256;
                pg8::EpiLrAtomic E2{WSP(float, WS_LR)};
                pg8::gemm_phase<pg8::EpiLrAtomic, 4, false, GP_SP2>(F.lds, F.tid, S2, 4, E2);
            }
            if (arg == pg8::M_FBL) { if (S.c >= S.nwg) { const int np = G - S.nwg; convert_misc<4>(F, S.c - S.nwg, np > 0 ? np : 1); } else if (G <= S.nwg) convert_misc<4>(F, c, G); }
        } else if (kind == K_G2) g2_phase(F);
        else if (kind == K_SCAN) scan_phase(F);
        else g4_phase(F);
}

#define LDP(i) ((const float*)(w_ + ldoff(tab, (i))))
#define STAGE_SETUP() \
        { int t_ = threadIdx.x; asm volatile("" : "+v"(t_)); F.tid = t_; F.lane = t_ & 63; F.wave = __builtin_amdgcn_readfirstlane(t_ >> 6); \
          size_t z_ = 0; asm volatile("" : "+s"(z_)); unsigned char* w_ = args.ws + z_; F.ws = w_; \
          const long long* tab = (const long long*)(w_ + WS_PTRTAB); \
          F.xp = LDP(0); F.xs = LDP(1); F.state = LDP(2); F.cnd = LDP(3); F.cctx = LDP(4); F.adaw = LDP(5); F.adab = LDP(6); F.npre = LDP(7); F.npost = LDP(8); \
          F.wgu = LDP(9); F.wdn = LDP(10); F.fw = LDP(11); F.gin = LDP(12); F.ggu = LDP(13); F.gbg = LDP(14); F.gnorm = LDP(15); F.gout = LDP(16); F.out = (float*)LDP(17); \
        }
__global__ void __launch_bounds__(512, 2) fwd_megakernel(Args args) {
    extern __shared__ __attribute__((aligned(16))) unsigned char lds_raw[];
    cg::grid_group grid = cg::this_grid();
    Frame F;
    F.lds = (LAS unsigned char*)lds_raw;
    const int G = gridDim.x, c = blockIdx.x;
    if (threadIdx.x < 16) ((LAS unsigned*)(F.lds + LDS_BARST))[threadIdx.x] = 0u;
    if (threadIdx.x == 0) { long long* tab = (long long*)(args.ws + WS_PTRTAB); const char* wb = (const char*)args.ws;
#pragma unroll
        for (int i = 0; i < 17; ++i) tab[i] = (long long)((const char*)args.in[i] - wb);
        tab[17] = (long long)((const char*)args.out - wb);
        __threadfence(); }
    __syncthreads();
    const XcdBarrier xbar = xcd_barrier_post((unsigned*)args.ws, (volatile LAS unsigned*)(F.lds + LDS_BARST));
#define RUN_STAGE(KIND, ARG, SYNC) do { constexpr int kind = (KIND), arg = (ARG); \
        STAGE_SETUP(); \
        stage_dispatch<kind, arg>(F, G, c); \
        if (SYNC) { if ((SYNC) == 2 && args.ws == nullptr) grid.sync(); xcd_barrier(xbar); } } while (0)
#define RUN_F32E(ARG, S, SLOT) do { \
        STAGE_SETUP(); \
        stage_dispatch<K_F32, (ARG)>(F, G, c); \
        if (G == 256) { pg8::Sched S_{}; S_.nM = 32; S_.nN = 8; S_.nZ = 1; S_.nM2 = 0; S_.nN2 = 1; S_.nwg = 256; S_.G = G; S_.c = c; S_.bm = 192; S_.lda = D; S_.ldb = D; S_.A = (const char*)F.ws; S_.B = S_.A; S_.A2 = S_.A; S_.B2 = S_.A; \
            pg8::Unit u_; (void)S_.next(0, u_); fused_elem(F, (S), (SLOT), u_.pm, u_.pn); } \
        else { xcd_barrier(xbar); STAGE_SETUP(); elem_phase(F, (S)); } \
        if ((S) < 6) xcd_barrier(xbar); } while (0)
    RUN_STAGE(K_PRO, 0, 2);
    RUN_STAGE(K_ELEM, 0, 1); RUN_STAGE(K_SWI, 0, 1); RUN_F32E(0, 1, 0);
    RUN_STAGE(K_BF, pg8::M_FA, 1); RUN_STAGE(K_BF, pg8::M_FBC, 0); RUN_STAGE(K_BF, pg8::M_FBL, 1); RUN_F32E(4, 2, 1);
    RUN_STAGE(K_SWI, 1, 1); RUN_F32E(1, 3, 2);
    RUN_STAGE(K_SWI, 2, 1); RUN_F32E(2, 4, 3);
    RUN_STAGE(K_BF, pg8::M_GIN, 1); RUN_STAGE(K_G2, 0, 1); RUN_STAGE(K_SCAN, 0, 1); RUN_STAGE(K_G4, 0, 1); RUN_F32E(5, 5, 4);
    RUN_STAGE(K_SWI, 3, 1); RUN_F32E(3, 6, 5);
#undef RUN_F32E
#undef RUN_STAGE
}

extern "C" void kernel_launch(void* const* d_in, const int* in_sizes, int n_in, void* d_out, int out_size, void* d_ws, size_t ws_size, hipStream_t stream) {
    static int grid_blocks = 0;
    if (grid_blocks == 0) {
        if (n_in != 17 || ws_size < WS_END) { fprintf(stderr, "kernel_launch: unexpected inputs (n_in %d, ws %zu)\n", n_in, ws_size); grid_blocks = -1; return; }
        int dev = 0, cus = 0, per_cu = 0;
        (void)hipGetDevice(&dev);
        (void)hipDeviceGetAttribute(&cus, hipDeviceAttributeMultiprocessorCount, dev);
        if (hipFuncSetAttribute((const void*)fwd_megakernel, hipFuncAttributeMaxDynamicSharedMemorySize, LDS_BYTES) != hipSuccess) { fprintf(stderr, "kernel_launch: hipFuncSetAttribute failed\n"); grid_blocks = -1; return; }
        if (hipOccupancyMaxActiveBlocksPerMultiprocessor(&per_cu, (const void*)fwd_megakernel, 512, LDS_BYTES) != hipSuccess || per_cu < 1) { fprintf(stderr, "kernel_launch: occupancy query failed (%d)\n", per_cu); (void)hipGetLastError(); per_cu = 1; }
        grid_blocks = cus * per_cu;
    }
    if (grid_blocks < 0) return;
    if (hipMemsetAsync(d_ws, 0, 131072, stream) != hipSuccess) { fprintf(stderr, "kernel_launch: memset of barrier words failed\n"); return; }
    Args a{};
    for (int i = 0; i < 17; ++i) a.in[i] = (const float*)d_in[i];
    a.out = (float*)d_out; a.ws = (unsigned char*)d_ws;
    void* kargs[] = {&a};
    hipError_t e = hipLaunchCooperativeKernel((const void*)fwd_megakernel, dim3(grid_blocks), dim3(512), kargs, LDS_BYTES, stream);
    if (e != hipSuccess) fprintf(stderr, "cooperative launch failed: %s (grid %d)\n", hipGetErrorString(e), grid_blocks);
}
```

```cpp
#include <hip/hip_runtime.h>
#include <hip/hip_cooperative_groups.h>
#include <cstdio>
#include <cstdint>
namespace cg = cooperative_groups;

#define LAS __attribute__((address_space(3)))
typedef unsigned short bf16_t;
typedef short bf16x8 __attribute__((ext_vector_type(8)));
typedef float f32x4 __attribute__((ext_vector_type(4)));
typedef float f32x2 __attribute__((ext_vector_type(2)));
typedef unsigned u32x4 __attribute__((ext_vector_type(4)));
typedef unsigned u32x2 __attribute__((ext_vector_type(2)));

constexpr int D = 2048, FF = 5632, NCTX = 4096, MROWS = 6144, NMOD = 9 * D;
constexpr int PLD = 6400;
constexpr float EPS = 1e-6f;
constexpr int LDS_BYTES = 157696 + 64, LDS_BARST = 157696;

constexpr size_t MiB = 1u << 20;
constexpr size_t WS_PTRTAB = 32768;
constexpr size_t WS_MOD = 1 * MiB, WS_SQ = 2 * MiB, WS_EL = 3 * MiB, WS_FCT = 4 * MiB, WS_CTC = 5 * MiB, WS_CTL = 6 * MiB;
constexpr size_t WS_LR = 11 * MiB;
constexpr size_t WS_COMB = 12 * MiB;
constexpr size_t WS_W1 = 16 * MiB, WS_W2 = 192 * MiB, WS_FW = 280 * MiB, WS_WO = 288 * MiB, WS_WA = 296 * MiB, WS_WV = 322 * MiB;
constexpr size_t WS_HB = 330 * MiB, WS_HID = 354 * MiB, WS_OUTF = 420 * MiB, WS_P = 468 * MiB, WS_VT = 543 * MiB, WS_QT = 567 * MiB, WS_KT = 591 * MiB;
constexpr size_t WS_KHT = 615 * MiB, WS_O = 639 * MiB, WS_ON = 735 * MiB, WS_YT = 759 * MiB, WS_FB = 807 * MiB, WS_END = 831 * MiB;
constexpr size_t W1_ELEMS = (size_t)11264 * 2048, W2_ELEMS = (size_t)2048 * 5632;

typedef __bf16 bf16x2_t __attribute__((ext_vector_type(2)));
__device__ __forceinline__ unsigned cvt_pk_bf16(float lo, float hi) { const bf16x2_t v = {(__bf16)lo, (__bf16)hi}; return __builtin_bit_cast(unsigned, v); }
__device__ __forceinline__ float bf2f(bf16_t b) { return __uint_as_float(((unsigned)b) << 16); }
__device__ __forceinline__ float wave_sum(float v) {
#pragma unroll
    for (int o = 1; o < 64; o <<= 1) v += __shfl_xor(v, o);
    return v;
}
__device__ __forceinline__ long long ldoff(const long long* tab, int i) {
    const unsigned long long v = (unsigned long long)__hip_atomic_load(tab + i, __ATOMIC_RELAXED, __HIP_MEMORY_SCOPE_AGENT);
    const unsigned lo = __builtin_amdgcn_readfirstlane((unsigned)v), hi = __builtin_amdgcn_readfirstlane((unsigned)(v >> 32));
    return (long long)(((unsigned long long)hi << 32) | lo);
}
__device__ __forceinline__ float silu_f(float g) { return g * __builtin_amdgcn_rcpf(1.0f + __expf(-g)); }

#ifndef GP_SP2
#define GP_SP2 true
#endif
#ifndef GP_ALIGN
#define GP_ALIGN true
#endif
namespace pg8 {
constexpr int BM = 256, BK = 64, HALF = 128, HTB = HALF * BK * 2, NXCD = 8, WGM = 4;
__device__ __forceinline__ int lds_byte(int r, int c) { const int st = (r >> 4) * 2 + (c >> 5), rr = r & 15, cc = c & 31, ob = rr * 64 + cc * 2; return st * 1024 + (ob ^ (((ob >> 9) & 1) << 5)); }
__device__ __forceinline__ void stage_rc(int b, int& R, int& C) { const int st = b / 1024, sb = b % 1024, swz = sb ^ (((sb >> 9) & 1) << 5); R = (st >> 1) * 16 + swz / 64; C = (st & 1) * 32 + (swz % 64) / 2; }
__device__ __forceinline__ int perm32(int rho) { const int n = rho >> 4, i = rho & 15; return 8 * (i >> 2) + 4 * n + (i & 3); }

struct Unit { const char* A; const char* B; int pm, pn, z; };
struct Sched {
    const char* A; const char* B; const char* A2; const char* B2;
    long sAz, sBz;
    int lda, ldb, nM, nN, nZ, nM2, nN2, nwg, G, c, bm;
    __device__ __forceinline__ bool next(int i, Unit& u) const {
        const long L = (long)i * G + c; if (L >= nwg) return false;
        int id = (int)L; { const int q = nwg / NXCD, r = nwg % NXCD, xcd = id % NXCD, off = id / NXCD; id = (xcd < r ? xcd * (q + 1) : r * (q + 1) + (xcd - r) * q) + off; }
        const int slab = nM * nN; int z = id / slab, lid = id - z * slab, tm = nM, tn = nN;
        const char* a = A + (long)z * sAz; const char* b = B + (long)z * sBz;
        if (z >= nZ) { z = nZ; lid = id - nZ * slab; tm = nM2; tn = nN2; a = A2; b = B2; }
        const int nig = WGM * tn, gid = lid / nig, fm = gid * WGM, gsz = (tm - fm) < WGM ? (tm - fm) : WGM;
        u.pm = fm + ((lid % nig) % gsz); u.pn = (lid % nig) / gsz; u.z = z;
        u.A = a + (size_t)u.pm * bm * lda * 2; u.B = b + (size_t)u.pn * BM * ldb * 2;
        return true;
    }
};

struct EpiF32Sq {
    static constexpr bool PERM = true;
    bf16_t* C; float* sq;
    __device__ __forceinline__ void operator()(const f32x4 (&acc)[2][2][3][2], const Unit& u, int wr, int wc, int fr, int fq) const {
        const int row0 = u.pm * 192 + wr * 48 + fr, col0 = u.pn * BM + wc * 32 + 8 * fq;
        const __amdgpu_buffer_rsrc_t rsrc = __builtin_amdgcn_make_buffer_rsrc(C, 0, MROWS * D * 2, 0x00020000);
#pragma unroll
        for (int ai = 0; ai < 2; ++ai)
#pragma unroll
            for (int m = 0; m < 3; ++m) {
                const int row = row0 + ai * 96 + m * 16; const unsigned roff = (unsigned)(row * D + col0) * 2u; float s = 0.f;
#pragma unroll
                for (int bj = 0; bj < 2; ++bj) { const f32x4 v0 = acc[ai][bj][m][0], v1 = acc[ai][bj][m][1];
                    s += (v0[0] * v0[0] + v0[1] * v0[1]) + (v0[2] * v0[2] + v0[3] * v0[3]) + (v1[0] * v1[0] + v1[1] * v1[1]) + (v1[2] * v1[2] + v1[3] * v1[3]);
                    u32x4 w; w.x = cvt_pk_bf16(v0[0], v0[1]); w.y = cvt_pk_bf16(v0[2], v0[3]); w.z = cvt_pk_bf16(v1[0], v1[1]); w.w = cvt_pk_bf16(v1[2], v1[3]);
                    __builtin_amdgcn_raw_buffer_store_b128(w, rsrc, roff + (unsigned)(bj * HALF * 2), 0, 16); }
                s += __shfl_xor(s, 16); s += __shfl_xor(s, 32);
                if (fq == 0) __hip_atomic_store(sq + (size_t)row * 32 + u.pn * 4 + wc, s, __ATOMIC_RELAXED, __HIP_MEMORY_SCOPE_AGENT);
            }
    }
};
template <int MT>
struct EpiSwiGLU {
    static constexpr bool PERM = true;
    bf16_t* H; int row_off, pn_off;
    __device__ __forceinline__ void operator()(const f32x4 (&acc)[2][2][MT][2], const Unit& u, int wr, int wc, int fr, int fq) const {
        const int row0 = u.pm * (64 * MT) + row_off + wr * (16 * MT) + fr, col0 = (u.pn + pn_off) * HALF + wc * 32 + 8 * fq;
        const __amdgpu_buffer_rsrc_t rsrc = __builtin_amdgcn_make_buffer_rsrc(H, 0, MROWS * FF * 2, 0x00020000);
#pragma unroll
        for (int ai = 0; ai < 2; ++ai)
#pragma unroll
            for (int m = 0; m < MT; ++m) {
                const unsigned roff = (unsigned)((row0 + ai * (32 * MT) + m * 16) * FF + col0) * 2u;
                const f32x4 g0 = acc[ai][0][m][0], g1 = acc[ai][0][m][1], u0 = acc[ai][1][m][0], u1 = acc[ai][1][m][1];
                u32x4 w;
                w.x = cvt_pk_bf16(silu_f(g0[0]) * u0[0], silu_f(g0[1]) * u0[1]); w.y = cvt_pk_bf16(silu_f(g0[2]) * u0[2], silu_f(g0[3]) * u0[3]);
                w.z = cvt_pk_bf16(silu_f(g1[0]) * u1[0], silu_f(g1[1]) * u1[1]); w.w = cvt_pk_bf16(silu_f(g1[2]) * u1[2], silu_f(g1[3]) * u1[3]);
                __builtin_amdgcn_raw_buffer_store_b128(w, rsrc, roff, 0, 16);
            }
    }
};
struct EpiLrAtomic {
    static constexpr bool PERM = false;
    float* LR;
    __device__ __forceinline__ void operator()(const f32x4 (&acc)[2][2][4][2], const Unit& u, int wr, int wc, int fr, int fq) const {
        if (wc != 0) return;
        const int row0 = u.pm * BM + wr * 64 + fr;
#pragma unroll
        for (int ai = 0; ai < 2; ++ai)
#pragma unroll
            for (int m = 0; m < 4; ++m) { float* rowp = LR + (size_t)(row0 + ai * HALF + m * 16) * 32 + 4 * fq;
#pragma unroll
                for (int n = 0; n < 2; ++n)
#pragma unroll
                    for (int j = 0; j < 4; ++j) atomicAdd(rowp + n * 16 + j, acc[ai][0][m][n][j]); }
    }
};
enum { M_GIN = 0, M_FA = 1, M_FBC = 2, M_FBL = 3 };
struct EpiBf16 {
    static constexpr bool PERM = true;
    int mode; bf16_t* d0; bf16_t* d1; unsigned char* wsb;
    __device__ __forceinline__ void operator()(const f32x4 (&acc)[2][2][4][2], const Unit& u, int wr, int wc, int fr, int fq) const {
        bf16_t* base; int ldc;
        if (mode == M_GIN) {
            if (u.z == 0) { base = d0 + (size_t)u.pm * BM * PLD + u.pn * BM; ldc = PLD; }
            else if (u.pn < 16) { base = d1 + (size_t)u.pn * (2048 * 256) + (size_t)u.pm * BM * 256; ldc = 256; }
            else { const int b = (u.pn - 16) >> 2, s0 = ((u.pn - 16) & 3) * 256; base = d1 + (size_t)16 * 2048 * 256 + (size_t)b * (2048 * 1024) + (size_t)u.pm * BM * 1024 + s0; ldc = 1024; }
        } else if (mode == M_FA) {
            const int g = u.z, chrow = g * 512 + (u.pm & 1) * 256, part = u.pm >> 1;
            if (u.pn < 16) { base = d0 + (size_t)u.pn * (2048 * 512) + (size_t)chrow * 512 + part * 256; ldc = 512; }
            else { const int b = (u.pn - 16) >> 2, s0 = ((u.pn - 16) & 3) * 256; base = d1 + (size_t)b * (2048 * 2048) + (size_t)chrow * 2048 + part * 1024 + s0; ldc = 2048; }
        } else if (mode == M_FBC) { base = d0 + (size_t)(u.z * 256) * D + u.pn * BM; ldc = D; }
        else { base = d0 + (size_t)(NCTX + u.z * 1024 + u.pm * BM) * D + u.pn * BM; ldc = D; }
        bf16_t* p0 = base + (size_t)(wr * 64 + fr) * ldc + wc * 32 + 8 * fq;
        const __amdgpu_buffer_rsrc_t rsrc = __builtin_amdgcn_make_buffer_rsrc(wsb, 0, 0x7fffffff, 0x00020000);
        const unsigned off0 = (unsigned)((const unsigned char*)p0 - wsb);
#pragma unroll
        for (int ai = 0; ai < 2; ++ai)
#pragma unroll
            for (int m = 0; m < 4; ++m) {
                const unsigned roff = off0 + (unsigned)((ai * HALF + m * 16) * ldc) * 2u;
#pragma unroll
                for (int bj = 0; bj < 2; ++bj) { const f32x4 v0 = acc[ai][bj][m][0], v1 = acc[ai][bj][m][1];
                    u32x4 w; w.x = cvt_pk_bf16(v0[0], v0[1]); w.y = cvt_pk_bf16(v0[2], v0[3]); w.z = cvt_pk_bf16(v1[0], v1[1]); w.w = cvt_pk_bf16(v1[2], v1[3]);
                    __builtin_amdgcn_raw_buffer_store_b128(w, rsrc, roff + (unsigned)(bj * HALF * 2), 0, 16); }
            }
    }
};

template <class Epi, int MT = 4, bool ALIGN_EPI = false, bool SP2 = false>
__device__ __forceinline__ void gemm_phase(LAS unsigned char* lds, const int tid, const Sched& S, const int nt, const Epi& E) {
    const int  wid = __builtin_amdgcn_readfirstlane(tid >> 6), lane = tid & 63, wr = wid >> 2, wc = wid & 3, fr = lane & 15, fq = lane >> 4;
    const int lda = S.lda, ldb = S.ldb;
    unsigned voffA[2], voffB[2];
#pragma unroll
    for (int i = 0; i < 2; ++i) { int R, C; stage_rc(tid * 16 + i * 8192, R, C); const int Rb = Epi::PERM ? ((R & ~31) + perm32(R & 31)) : R;
        const int Ra = (R >= 32 * MT) ? R - (128 - 32 * MT) : R;
        voffA[i] = (unsigned)(Ra * lda + C) * 2u; voffB[i] = (unsigned)(Rb * ldb + C) * 2u; }
    const size_t kstep = (size_t)(BK * 2);
    const size_t hstepA = (size_t)(32 * MT) * lda * 2, hstepB = (size_t)HALF * ldb * 2;
    const unsigned ldsw = (unsigned)wid * 1024u;
    const int aoff = lds_byte(wr * (16 * MT) + fr, fq * 8), boff = lds_byte(wc * 32 + fr, fq * 8);
#define PG8_SA(b, h) (((b) * 2 + (h)) * HTB)
#define PG8_SB(b, h) ((4 + (b) * 2 + (h)) * HTB)
#define PG8_STAGE(bufoff, gbase, voff) do { _Pragma("unroll") for (int _i = 0; _i < 2; ++_i) \
        __builtin_amdgcn_global_load_lds((const unsigned*)((const char*)(gbase) + (voff)[_i]), (LAS unsigned*)(lds + (bufoff) + ldsw + _i * 8192), 16, 0, 0); } while (0)
#define PG8_LDA(dst, b, h) do { _Pragma("unroll") for (int m = 0; m < MT; ++m) _Pragma("unroll") for (int k = 0; k < 2; ++k) dst[m][k] = *(const LAS bf16x8*)(lds + PG8_SA(b, h) + aoff + m * 2048 + k * 1024); } while (0)
#define PG8_LDB(dst, b, h) do { _Pragma("unroll") for (int n = 0; n < 2; ++n) _Pragma("unroll") for (int k = 0; k < 2; ++k) dst[n][k] = *(const LAS bf16x8*)(lds + PG8_SB(b, h) + boff + n * 2048 + k * 1024); } while (0)
#define PG8_MMA(ai, bj, At, Bt) do { __builtin_amdgcn_s_setprio(1); _Pragma("unroll") for (int m = 0; m < MT; ++m) _Pragma("unroll") for (int n = 0; n < 2; ++n) _Pragma("unroll") for (int k = 0; k < 2; ++k) \
        acc[ai][bj][m][n] = __builtin_amdgcn_mfma_f32_16x16x32_bf16(Bt[n][k], At[m][k], acc[ai][bj][m][n], 0, 0, 0); __builtin_amdgcn_s_setprio(0); } while (0)
#define PG8_WAIT_V(n) asm volatile("s_waitcnt vmcnt(" #n ")" ::: "memory")
#define PG8_WAIT_L(n) asm volatile("s_waitcnt lgkmcnt(" #n ")" ::: "memory")
#define PG8_BAR __builtin_amdgcn_s_barrier()
#define PG8_SCHED __builtin_amdgcn_sched_barrier(0)
    Unit cur, nxt; int ui = 0;
    if (!S.next(0, cur)) return;
    f32x4 acc[2][2][MT][2];
    float zz = 0.f; asm volatile("" : "+v"(zz));
#pragma unroll
    for (int a = 0; a < 2; ++a)
#pragma unroll
        for (int b = 0; b < 2; ++b)
#pragma unroll
            for (int m = 0; m < MT; ++m)
#pragma unroll
                for (int n = 0; n < 2; ++n) acc[a][b][m][n] = (f32x4){zz, zz, zz, zz};
    bf16x8 At[MT][2], B0[2][2], B1[2][2];
    const char* cA = cur.A; const char* cB = cur.B;
    if constexpr (SP2) {
        PG8_STAGE(PG8_SB(0, 0), cB, voffB); PG8_STAGE(PG8_SB(0, 1), cB + hstepB, voffB); PG8_STAGE(PG8_SA(0, 0), cA, voffA); PG8_STAGE(PG8_SA(0, 1), cA + hstepA, voffA);
        if (wr == 1) PG8_BAR;
        PG8_WAIT_V(2); PG8_BAR;
        PG8_STAGE(PG8_SB(1, 0), cB + kstep, voffB); PG8_STAGE(PG8_SA(1, 0), cA + kstep, voffA); PG8_STAGE(PG8_SB(1, 1), cB + hstepB + kstep, voffB);
        PG8_WAIT_V(6); PG8_BAR;
    } else {
    PG8_STAGE(PG8_SB(0, 0), cB, voffB); PG8_STAGE(PG8_SA(0, 0), cA, voffA); PG8_STAGE(PG8_SB(0, 1), cB + hstepB, voffB); PG8_STAGE(PG8_SA(0, 1), cA + hstepA, voffA);
    if (wr == 1) PG8_BAR;
    PG8_WAIT_V(4); PG8_BAR;
    PG8_STAGE(PG8_SB(1, 0), cB + kstep, voffB); PG8_STAGE(PG8_SA(1, 0), cA + kstep, voffA); PG8_STAGE(PG8_SB(1, 1), cB + hstepB + kstep, voffB);
    PG8_WAIT_V(6); PG8_BAR;
    }
    for (;;) {
        const bool has_next = S.next(ui + 1, nxt);
        const char* nA = has_next ? nxt.A : cA; const char* nB = has_next ? nxt.B : cB;
        for (int t = 0; t < nt; t += 2) {
            const bool last = (t == nt - 2);
            const char* a1 = cA + (size_t)(t + 1) * kstep;
            const char* a2 = last ? nA : cA + (size_t)(t + 2) * kstep; const char* b2 = last ? nB : cB + (size_t)(t + 2) * kstep;
            const char* a3 = a2 + kstep; const char* b3 = b2 + kstep;
            if constexpr (SP2) {
            PG8_LDB(B0, 0, 0); PG8_LDB(B1, 0, 1); PG8_SCHED; PG8_LDA(At, 0, 0); PG8_STAGE(PG8_SA(1, 1), a1 + hstepA, voffA);
            PG8_WAIT_V(8); PG8_WAIT_L(0); PG8_BAR; PG8_MMA(0, 0, At, B0); PG8_MMA(0, 1, At, B1); PG8_BAR; PG8_SCHED;
            PG8_LDA(At, 0, 1); PG8_STAGE(PG8_SB(0, 0), b2, voffB); PG8_STAGE(PG8_SB(0, 1), b2 + hstepB, voffB); PG8_STAGE(PG8_SA(0, 0), a2, voffA);
            PG8_WAIT_V(8); PG8_WAIT_L(0); PG8_BAR; PG8_MMA(1, 0, At, B0); PG8_MMA(1, 1, At, B1); PG8_BAR; PG8_SCHED;
            PG8_LDB(B0, 1, 0); PG8_LDB(B1, 1, 1); PG8_SCHED; PG8_LDA(At, 1, 0); PG8_STAGE(PG8_SA(0, 1), a2 + hstepA, voffA);
            PG8_WAIT_V(8); PG8_WAIT_L(0); PG8_BAR; PG8_MMA(0, 0, At, B0); PG8_MMA(0, 1, At, B1); PG8_BAR; PG8_SCHED;
            PG8_LDA(At, 1, 1); PG8_STAGE(PG8_SB(1, 0), b3, voffB); PG8_STAGE(PG8_SB(1, 1), b3 + hstepB, voffB); PG8_STAGE(PG8_SA(1, 0), a3, voffA);
            PG8_WAIT_V(8); PG8_WAIT_L(0); PG8_BAR; PG8_MMA(1, 0, At, B0); PG8_MMA(1, 1, At, B1); PG8_BAR; PG8_SCHED;
            } else {
            PG8_LDB(B0, 0, 0); PG8_SCHED; PG8_LDA(At, 0, 0); PG8_STAGE(PG8_SA(1, 1), a1 + hstepA, voffA);
            PG8_WAIT_L(8); PG8_BAR; PG8_WAIT_L(0); PG8_MMA(0, 0, At, B0); PG8_BAR; PG8_SCHED;
            PG8_LDB(B1, 0, 1); PG8_STAGE(PG8_SB(0, 0), b2, voffB);
            PG8_BAR; PG8_WAIT_L(0); PG8_MMA(0, 1, At, B1); PG8_BAR;
            PG8_LDA(At, 0, 1); PG8_STAGE(PG8_SA(0, 0), a2, voffA);
            PG8_BAR; PG8_WAIT_L(0); PG8_MMA(1, 0, At, B0); PG8_BAR; PG8_SCHED;
            PG8_STAGE(PG8_SB(0, 1), b2 + hstepB, voffB);
            PG8_WAIT_V(6); PG8_BAR; PG8_MMA(1, 1, At, B1); PG8_BAR;
            PG8_LDB(B0, 1, 0); PG8_SCHED; PG8_LDA(At, 1, 0); PG8_STAGE(PG8_SA(0, 1), a2 + hstepA, voffA);
            PG8_WAIT_L(8); PG8_BAR; PG8_WAIT_L(0); PG8_MMA(0, 0, At, B0); PG8_BAR; PG8_SCHED;
            PG8_LDB(B1, 1, 1); PG8_STAGE(PG8_SB(1, 0), b3, voffB);
            PG8_BAR; PG8_WAIT_L(0); PG8_MMA(0, 1, At, B1); PG8_BAR;
            PG8_LDA(At, 1, 1); PG8_STAGE(PG8_SA(1, 0), a3, voffA);
            PG8_BAR; PG8_WAIT_L(0); PG8_MMA(1, 0, At, B0); PG8_BAR; PG8_SCHED;
            PG8_STAGE(PG8_SB(1, 1), b3 + hstepB, voffB);
            PG8_WAIT_V(6); PG8_BAR; PG8_MMA(1, 1, At, B1); PG8_BAR;
            }
        }
        if constexpr (ALIGN_EPI) { if (wr == 0) PG8_BAR; }
        E(acc, cur, wr, wc, fr, fq);
        if (!has_next) break;
#pragma unroll
        for (int a = 0; a < 2; ++a)
#pragma unroll
            for (int b = 0; b < 2; ++b)
#pragma unroll
                for (int m = 0; m < MT; ++m)
#pragma unroll
                    for (int n = 0; n < 2; ++n) acc[a][b][m][n] = (f32x4){zz, zz, zz, zz};
        cur = nxt; cA = nA; cB = nB; ++ui;
        if constexpr (ALIGN_EPI) { if (wr == 1) PG8_BAR; }
    }
    PG8_WAIT_V(0);
    if constexpr (!ALIGN_EPI) { if (wr == 0) PG8_BAR; }
    PG8_BAR;
#undef PG8_SA
#undef PG8_SB
#undef PG8_STAGE
#undef PG8_LDA
#undef PG8_LDB
#undef PG8_MMA
#undef PG8_WAIT_V
#undef PG8_WAIT_L
#undef PG8_BAR
#undef PG8_SCHED
}
}


#define XB_TMO      128
#define XB_XCNT(j)  (256  + 64 * (j))
#define XB_XSUB(j)  (1280 + 64 * (j))
#define XB_XGEN(j)  (2304 + 64 * (j))
#define XB_TOP      3328
#define XB_TOPGEN   3392
#define XCD_BAR_WORDS 3456
#define XB_SPIN_CAP (1u << 18)
__device__ __forceinline__ unsigned xb_ld(unsigned* p)              { return __hip_atomic_load(p, __ATOMIC_RELAXED, __HIP_MEMORY_SCOPE_AGENT); }
__device__ __forceinline__ unsigned xb_add(unsigned* p, unsigned v) { return __hip_atomic_fetch_add(p, v, __ATOMIC_RELAXED, __HIP_MEMORY_SCOPE_AGENT); }
__device__ __forceinline__ unsigned xb_xcc_id() { return (unsigned)__builtin_amdgcn_s_getreg((3 << 11) | 20) & 0xFu; }
#define XB_SPIN(cond, bar) do { unsigned _sp = 0; while (cond) { __builtin_amdgcn_s_sleep(1); \
    if ((++_sp & 255u) == 0u) { if (xb_ld(&(bar)[XB_TMO])) break; if (_sp > XB_SPIN_CAP) { atomicAdd(&(bar)[XB_TMO], 1u); break; } } } } while (0)
struct XcdBarrier { unsigned* bar; unsigned x; volatile LAS unsigned* st; };
__device__ __forceinline__ XcdBarrier xcd_barrier_post(unsigned* bar, volatile LAS unsigned* st) {
    XcdBarrier b; b.bar = bar; b.x = xb_xcc_id(); b.st = st;
    if (threadIdx.x == 0) (void)xb_add(&bar[XB_XCNT(b.x)], 1u);
    return b;
}
__device__ __forceinline__ void xcd_barrier_complete(unsigned* bar, unsigned x, unsigned& nloc, unsigned& nx) {
    const unsigned G = gridDim.x * gridDim.y * gridDim.z;
    unsigned sum, cnt, mine, sp = 0u;
    for (;;) {
        sum = 0u; cnt = 0u; mine = 0u;
#pragma unroll
        for (unsigned j = 0; j < 16; ++j) { const unsigned c = xb_ld(&bar[XB_XCNT(j)]); sum += c; cnt += (c > 0u) ? 1u : 0u; mine = (j == x) ? c : mine; }
        if (sum == G) break;
        __builtin_amdgcn_s_sleep(1);
        if ((++sp & 255u) == 0u) { if (xb_ld(&bar[XB_TMO])) break; if (sp > XB_SPIN_CAP) { atomicAdd(&bar[XB_TMO], 1u); break; } }
    }
    nloc = mine > 0u ? mine : 1u; nx = cnt > 0u ? cnt : 1u;
}
__device__ __forceinline__ void xcd_barrier(const XcdBarrier& b) {
    asm volatile("s_waitcnt vmcnt(0)" ::: "memory");
    __syncthreads();
    if (threadIdx.x == 0) {
        unsigned* bar = b.bar;
        __builtin_amdgcn_s_waitcnt(0);
        unsigned nloc = b.st[0], nx = b.st[1];
        if (nloc == 0u) { xcd_barrier_complete(bar, b.x, nloc, nx); b.st[0] = nloc; b.st[1] = nx; }
        const unsigned old = xb_add(&bar[XB_XSUB(b.x)], 1u);
        const unsigned gen = old / nloc;
        if (old + 1u == (gen + 1u) * nloc) {
            __builtin_amdgcn_fence(__ATOMIC_RELEASE, "agent");
            asm volatile("s_waitcnt vmcnt(0)" ::: "memory");
            const unsigned og = xb_add(&bar[XB_TOP], 1u);
            const unsigned tg = og / nx;
            if (og + 1u == (tg + 1u) * nx) xb_add(&bar[XB_TOPGEN], 1u);
            else XB_SPIN(xb_ld(&bar[XB_TOPGEN]) == tg, bar);
            __builtin_amdgcn_fence(__ATOMIC_ACQUIRE, "agent");
            xb_add(&bar[XB_XGEN(b.x)], 1u);
            asm volatile("s_waitcnt vmcnt(0)" ::: "memory");
        } else {
            XB_SPIN(xb_ld(&bar[XB_XGEN(b.x)]) == gen, bar);
            __builtin_amdgcn_fence(__ATOMIC_ACQUIRE, "agent");
            asm volatile("s_waitcnt vmcnt(0)" ::: "memory");
        }
    }
    __syncthreads();
}

struct Args { const float* in[17]; float* out; unsigned char* ws; };
struct Frame {
    LAS unsigned char* lds; int tid, lane, wave;
    const float *xp, *xs, *state, *cnd, *cctx, *adaw, *adab, *npre, *npost, *wgu, *wdn, *fw, *gin, *ggu, *gbg, *gnorm, *gout;
    float* out; unsigned char* ws;
};
#define WSP(T, off) ((T*)(F.ws + (off)))

__device__ __forceinline__ void transpose_item(const float* W, int N, bf16_t* WT, int K, int dst_row0, LAS float* scr, int k0, int n0, int lane) {
    float v_[32];
#pragma unroll
    for (int i = 0; i < 32; ++i) { const int kk = 2 * i + (lane >> 5); v_[i] = __builtin_nontemporal_load(W + (size_t)(k0 + kk) * N + n0 + (lane & 31)); }
#pragma unroll
    for (int i = 0; i < 32; ++i) { const int kk = 2 * i + (lane >> 5); scr[kk * 33 + (lane & 31)] = v_[i]; }
    asm volatile("s_waitcnt lgkmcnt(0)" ::: "memory");
    const int c = lane & 7;
#pragma unroll
    for (int j = 0; j < 4; ++j) { const int n = (lane >> 3) + 8 * j; const LAS float* s = scr + (8 * c) * 33 + n;
        u32x4 o; o.x = cvt_pk_bf16(s[0 * 33], s[1 * 33]); o.y = cvt_pk_bf16(s[2 * 33], s[3 * 33]); o.z = cvt_pk_bf16(s[4 * 33], s[5 * 33]); o.w = cvt_pk_bf16(s[6 * 33], s[7 * 33]);
        *(u32x4*)(WT + (size_t)(dst_row0 + n) * K + k0 + 8 * c) = o; }
    asm volatile("s_waitcnt lgkmcnt(0)" ::: "memory");
}


struct TItem { const float* W; bf16_t* WT; int N, K, dr, k0, n0; };
__device__ __forceinline__ void ti_load(const TItem& t, int lane, float (&v)[32]) {
#pragma unroll
    for (int i = 0; i < 32; ++i) { const int kk = 2 * i + (lane >> 5); v[i] = __builtin_nontemporal_load(t.W + (size_t)(t.k0 + kk) * t.N + t.n0 + (lane & 31)); }
}
__device__ __forceinline__ void ti_store(const TItem& t, LAS float* scr, int lane, const float (&v)[32]) {
#pragma unroll
    for (int i = 0; i < 32; ++i) { const int kk = 2 * i + (lane >> 5); scr[kk * 33 + (lane & 31)] = v[i]; }
    asm volatile("s_waitcnt lgkmcnt(0)" ::: "memory");
    const int c = lane & 7;
#pragma unroll
    for (int j = 0; j < 4; ++j) { const int n = (lane >> 3) + 8 * j; const LAS float* s = scr + (8 * c) * 33 + n;
        u32x4 o; o.x = cvt_pk_bf16(s[0 * 33], s[1 * 33]); o.y = cvt_pk_bf16(s[2 * 33], s[3 * 33]); o.z = cvt_pk_bf16(s[4 * 33], s[5 * 33]); o.w = cvt_pk_bf16(s[6 * 33], s[7 * 33]);
        *(u32x4*)(t.WT + (size_t)(t.dr + n) * t.K + t.k0 + 8 * c) = o; }
    asm volatile("s_waitcnt lgkmcnt(0)" ::: "memory");
}
__device__ __forceinline__ void convert_ffn(Frame& F, int f, int part, int nparts) {
    LAS float* scr = (LAS float*)(F.lds + F.wave * 16384);
    const int gw = part * 8 + F.wave, NGW = nparts * 8, lane = F.lane;
    constexpr int I1 = 32 * 352, I2 = 88 * 64, NIT = I1 + I2;
    const float* w1 = F.wgu + (size_t)f * D * 11264; bf16_t* w1t = WSP(bf16_t, WS_W1) + (size_t)f * W1_ELEMS;
    const float* w2 = F.wdn + (size_t)f * FF * D; bf16_t* w2t = WSP(bf16_t, WS_W2) + (size_t)f * W2_ELEMS;
#define FFN_DECODE(it_, T) do { int r_ = (it_); \
        if (r_ < I1) { const int kb = r_ / 352, nb = r_ % 352, n0 = nb * 32; T.W = w1; T.WT = w1t; T.N = 11264; T.K = D; T.k0 = kb * 64; T.n0 = n0; \
            T.dr = (n0 < FF) ? ((n0 >> 7) * 256 + (n0 & 127)) : ((((n0 - FF) >> 7) * 256) + 128 + ((n0 - FF) & 127)); } \
        else { r_ -= I1; const int kb = r_ / 64, nb = r_ % 64; T.W = w2; T.WT = w2t; T.N = D; T.K = FF; T.k0 = kb * 64; T.n0 = nb * 32; T.dr = nb * 32; } } while (0)
    int it = gw; if (it >= NIT) return;
    TItem ta, tb; float va[32], vb[32];
    FFN_DECODE(it, ta); ti_load(ta, lane, va);
    for (;;) {
        int nx = it + NGW; bool has = nx < NIT;
        if (has) { FFN_DECODE(nx, tb); ti_load(tb, lane, vb); }
        ti_store(ta, scr, lane, va);
        if (!has) break;
        it = nx; nx = it + NGW; has = nx < NIT;
        if (has) { FFN_DECODE(nx, ta); ti_load(ta, lane, va); }
        ti_store(tb, scr, lane, vb);
        if (!has) break;
        it = nx;
    }
#undef FFN_DECODE
}
template <int WHAT>
__device__ __forceinline__ void convert_misc(Frame& F, int part, int nparts) {
    LAS float* scr = (LAS float*)(F.lds + F.wave * 16384);
    const int gw = part * 8 + F.wave, NGW = nparts * 8, lane = F.lane;
    constexpr int I3 = 32 * 64, I5 = 32 * 257;
    for (int it = gw; it < 2 * I3 + I5; it += NGW) {
        int r = it;
        if (r < I3) { if (WHAT & 1) { const int kb = r / 64, nb = r % 64; transpose_item(F.fw, D, WSP(bf16_t, WS_FW), D, nb * 32, scr, kb * 64, nb * 32, lane); } continue; }
        r -= I3;
        if (r < I3) { if (WHAT & 2) { const int kb = r / 64, nb = r % 64; transpose_item(F.gout, D, WSP(bf16_t, WS_WO), D, nb * 32, scr, kb * 64, nb * 32, lane); } continue; }
        r -= I3;
        if (WHAT & 4) { const int kb = r / 257, nb = r % 257, n0 = nb * 32;
          if (n0 < 4096) transpose_item(F.gin, 8224, WSP(bf16_t, WS_WA), D, n0, scr, kb * 64, n0, lane);
          else if (n0 < 6144) transpose_item(F.gin, 8224, WSP(bf16_t, WS_WV), D, n0 - 4096, scr, kb * 64, n0, lane);
          else transpose_item(F.gin, 8224, WSP(bf16_t, WS_WA), D, n0 - 2048, scr, kb * 64, n0, lane); }
    }
    const size_t gt = (size_t)part * 512 + F.tid, NT = (size_t)nparts * 512;
    if (WHAT & 4) { u32x4* wz = (u32x4*)(WSP(bf16_t, WS_WA) + (size_t)6176 * D);
        for (size_t e = gt; e < (size_t)224 * D / 8; e += NT) wz[e] = (u32x4){0u, 0u, 0u, 0u}; }
}

__device__ __forceinline__ void prologue(Frame& F) {
    const int tid = F.tid, lane = F.lane, wave = F.wave, G = gridDim.x;
    {
        LAS float* Ss = (LAS float*)F.lds;
        LAS float* Red = (LAS float*)(F.lds + 24576);
        for (int e = tid; e < 3 * D; e += 512) { const int c = e >> 11, k = e & 2047; const float v = (c == 0) ? F.cctx[k] : F.cnd[(c - 1) * D + k]; Ss[e] = v / (1.0f + __expf(-v)); }
        __syncthreads();
        float* MOD = WSP(float, WS_MOD);
        for (int it = blockIdx.x; it < 256; it += G) {
            const int l = it >> 7, col0 = (it & 127) * 144; const bool on = lane < 36;
            const float* Wp = F.adaw + (size_t)l * D * NMOD + (size_t)(wave * 256) * NMOD + col0 + 4 * (on ? lane : 0);
            f32x4 a0 = {0.f, 0.f, 0.f, 0.f}, a1 = a0, a2 = a0;
            if (on) {
                for (int kb = 0; kb < 256; kb += 16) {
                    f32x4 w[16];
#pragma unroll
                    for (int j = 0; j < 16; ++j) w[j] = __builtin_nontemporal_load((const f32x4*)(Wp + (size_t)(kb + j) * NMOD));
#pragma unroll
                    for (int j = 0; j < 16; ++j) { const int k = wave * 256 + kb + j; const float s0 = Ss[k], s1 = Ss[D + k], s2 = Ss[2 * D + k];
                        a0 += w[j] * s0; a1 += w[j] * s1; a2 += w[j] * s2; }
                }
                *(LAS f32x4*)(Red + (wave * 3 + 0) * 144 + 4 * lane) = a0; *(LAS f32x4*)(Red + (wave * 3 + 1) * 144 + 4 * lane) = a1; *(LAS f32x4*)(Red + (wave * 3 + 2) * 144 + 4 * lane) = a2;
            }
            __syncthreads();
            if (tid < 432) { const int c = tid / 144, n = tid % 144; float s = 0.f;
#pragma unroll
                for (int w8 = 0; w8 < 8; ++w8) s += Red[(w8 * 3 + c) * 144 + n];
                MOD[(size_t)(l * 3 + c) * NMOD + col0 + n] = s + F.adab[(size_t)l * NMOD + col0 + n]; }
            __syncthreads();
        }
    }
    convert_ffn(F, 0, blockIdx.x, G);
    {
        const size_t gt = (size_t)blockIdx.x * 512 + tid, NT = (size_t)G * 512;
        for (size_t e = gt; e < (size_t)1024 * 64; e += NT) { const int row = (int)(e >> 6), k0 = (int)(e & 63) * 8, n = row & 511; const bool sn = row >= 512; float v[8];
#pragma unroll
            for (int j = 0; j < 8; ++j) { const int m = (n * (k0 + j)) & 511; float s, c; sincospif((float)m * (1.0f / 256.0f), &s, &c); v[j] = (sn ? s : c) * 0.044194173824159216f; }
            u32x4 o; o.x = cvt_pk_bf16(v[0], v[1]); o.y = cvt_pk_bf16(v[2], v[3]); o.z = cvt_pk_bf16(v[4], v[5]); o.w = cvt_pk_bf16(v[6], v[7]);
            *(u32x4*)(WSP(bf16_t, WS_FCT) + (size_t)row * 512 + k0) = o; }
        for (size_t e = gt; e < (size_t)256 * 64; e += NT) { const int row = (int)(e >> 6), k0 = (int)(e & 63) * 8; float v[8];
#pragma unroll
            for (int j = 0; j < 8; ++j) { const int kk = k0 + j, s_ = kk & 255; const int m = (row * s_) & 255; float s, c; sincospif((float)m * (1.0f / 128.0f), &s, &c); v[j] = (kk >= 256 ? -s : c) * 0.0625f; }
            u32x4 o; o.x = cvt_pk_bf16(v[0], v[1]); o.y = cvt_pk_bf16(v[2], v[3]); o.z = cvt_pk_bf16(v[4], v[5]); o.w = cvt_pk_bf16(v[6], v[7]);
            *(u32x4*)(WSP(bf16_t, WS_CTC) + (size_t)row * 512 + k0) = o; }
        for (size_t e = gt; e < (size_t)1024 * 256; e += NT) { const int row = (int)(e >> 8), k0 = (int)(e & 255) * 8; float v[8];
#pragma unroll
            for (int j = 0; j < 8; ++j) { const int kk = k0 + j, s_ = kk & 1023; const int m = (row * s_) & 1023; float s, c; sincospif((float)m * (1.0f / 512.0f), &s, &c); v[j] = (kk >= 1024 ? -s : c) * 0.03125f; }
            u32x4 o; o.x = cvt_pk_bf16(v[0], v[1]); o.y = cvt_pk_bf16(v[2], v[3]); o.z = cvt_pk_bf16(v[4], v[5]); o.w = cvt_pk_bf16(v[6], v[7]);
            *(u32x4*)(WSP(bf16_t, WS_CTL) + (size_t)row * 2048 + k0) = o; }
    }
}

__device__ __forceinline__ void elem_phase(Frame& F, int s) {
    const int gw = blockIdx.x * 8 + F.wave, NGW = gridDim.x * 8, lane = F.lane;
    const float* MOD = WSP(float, WS_MOD); const float* SQ = WSP(float, WS_SQ); const bf16_t* OUTB = WSP(bf16_t, WS_OUTF); bf16_t* HB = WSP(bf16_t, WS_HB);
    float* COMB = WSP(float, WS_COMB);
    if (s == 0) {
        for (int idx = gw; idx < 54 * 8; idx += NGW) { const int t = idx >> 3, col = (idx & 7) * 256 + 4 * lane, v = t % 3, k = (t / 3) % 3, cc = (t / 9) % 3, l = t / 27;
            const float* m = MOD + (size_t)(l * 3 + cc) * NMOD; f32x4 r;
            if (v == 0) { const float w = (k == 1) ? 1.0f : 0.5f; r = *(const f32x4*)(m + (3 * k + 2) * D + col) * *(const f32x4*)(F.npost + (size_t)(l * 3 + k) * D + col) * w; }
            else if (v == 1) r = *(const f32x4*)(F.npre + (size_t)(l * 3 + k) * D + col) * (*(const f32x4*)(m + (3 * k + 1) * D + col) + 1.0f);
            else r = *(const f32x4*)(m + (3 * k) * D + col);
            *(f32x4*)(COMB + (size_t)t * D + col) = r; }
        for (int r = gw; r < MROWS; r += NGW) {
            const int cidx = r < NCTX ? 0 : 1 + ((r - NCTX) >> 10);
            const float* xin = r < NCTX ? F.xp + (size_t)r * D : F.xs + (size_t)(r - NCTX) * D;
            f32x4 x[8], g[8], a[8], b[8];
            const f32x4* gpr = (const f32x4*)F.npre; const f32x4* sh = (const f32x4*)(MOD + (size_t)cidx * NMOD); const f32x4* sc = (const f32x4*)(MOD + (size_t)cidx * NMOD + D);
#pragma unroll
            for (int j = 0; j < 8; ++j) { x[j] = ((const f32x4*)xin)[lane + 64 * j]; g[j] = gpr[lane + 64 * j]; a[j] = sh[lane + 64 * j]; b[j] = sc[lane + 64 * j]; }
            float ss = 0.f;
#pragma unroll
            for (int j = 0; j < 8; ++j) ss += (x[j][0] * x[j][0] + x[j][1] * x[j][1]) + (x[j][2] * x[j][2] + x[j][3] * x[j][3]);
            const float rr = rsqrtf(wave_sum(ss) * (1.0f / D) + EPS);
            u32x2* hb = (u32x2*)(HB + (size_t)r * D);
#pragma unroll
            for (int j = 0; j < 8; ++j) { const f32x4 h = x[j] * rr * g[j] * (b[j] + 1.0f) + a[j]; u32x2 o; o.x = cvt_pk_bf16(h[0], h[1]); o.y = cvt_pk_bf16(h[2], h[3]); hb[lane + 64 * j] = o; }
        }
        return;
    }
    const int lp = (s - 1) / 3, kp = (s - 1) % 3, l = s / 3, k = s % 3;
    for (int r = gw; r < MROWS; r += NGW) {
        const int cidx = r < NCTX ? 0 : 1 + ((r - NCTX) >> 10);
        const float* xin = (s <= 1) ? (r < NCTX ? F.xp + (size_t)r * D : F.xs + (size_t)(r - NCTX) * D) : F.out + (size_t)r * D;
        const f32x4* Gp = (const f32x4*)(COMB + (size_t)(((lp * 3 + cidx) * 3 + kp) * 3 + 0) * D);
        const f32x4* Ap = (const f32x4*)(COMB + (size_t)(((l * 3 + cidx) * 3 + k) * 3 + 1) * D);
        const f32x4* Bp = (const f32x4*)(COMB + (size_t)(((l * 3 + cidx) * 3 + k) * 3 + 2) * D);
        const u32x2* o4 = (const u32x2*)(OUTB + (size_t)r * D);
        f32x4 x[8], g[8], a[8], b[8]; u32x2 ov[8];
        const float part = lane < 32 ? SQ[(size_t)r * 32 + lane] : 0.f;
#pragma unroll
        for (int j = 0; j < 8; ++j) { x[j] = ((const f32x4*)xin)[lane + 64 * j]; ov[j] = o4[lane + 64 * j]; g[j] = Gp[lane + 64 * j]; }
        if (s < 6) {
#pragma unroll
            for (int j = 0; j < 8; ++j) { a[j] = Ap[lane + 64 * j]; b[j] = Bp[lane + 64 * j]; }
        }
        const float rs = rsqrtf(wave_sum(part) * (1.0f / D) + EPS);
#pragma unroll
        for (int j = 0; j < 8; ++j) {
            const f32x4 o = {__uint_as_float(ov[j].x << 16), __uint_as_float(ov[j].x & 0xffff0000u), __uint_as_float(ov[j].y << 16), __uint_as_float(ov[j].y & 0xffff0000u)};
            x[j] += g[j] * (o * rs); }
#pragma unroll
        for (int j = 0; j < 8; ++j) ((f32x4*)(F.out + (size_t)r * D))[lane + 64 * j] = x[j];
        if (s == 4 && lane < 32) WSP(float, WS_LR)[(size_t)r * 32 + lane] = 0.f;
        if (s < 6) {
            float ss = 0.f;
#pragma unroll
            for (int j = 0; j < 8; ++j) ss += (x[j][0] * x[j][0] + x[j][1] * x[j][1]) + (x[j][2] * x[j][2] + x[j][3] * x[j][3]);
            const float rr = rsqrtf(wave_sum(ss) * (1.0f / D) + EPS);
            u32x2* hb = (u32x2*)(HB + (size_t)r * D);
#pragma unroll
            for (int j = 0; j < 8; ++j) { const f32x4 h = x[j] * rr * a[j] + b[j]; u32x2 o; o.x = cvt_pk_bf16(h[0], h[1]); o.y = cvt_pk_bf16(h[2], h[3]); hb[lane + 64 * j] = o; }
        }
    }
}

constexpr size_t WS_PCNT = 65536;
__device__ __forceinline__ void fused_elem(Frame& F, const int s, const int slot, const int pm, const int pn) {
    const int lane = F.lane, rbase = pm * 192 + pn * 24 + F.wave * 3;
    const bf16_t* OUTB = WSP(bf16_t, WS_OUTF); const float* SQ = WSP(float, WS_SQ); bf16_t* HB = WSP(bf16_t, WS_HB); const float* COMB = WSP(float, WS_COMB);
    f32x4 x[3][8];
#pragma unroll
    for (int q = 0; q < 3; ++q) { const int r = rbase + q;
        const float* xin = (s <= 1) ? (r < NCTX ? F.xp + (size_t)r * D : F.xs + (size_t)(r - NCTX) * D) : F.out + (size_t)r * D;
#pragma unroll
        for (int j = 0; j < 8; ++j) x[q][j] = ((const f32x4*)xin)[lane + 64 * j]; }
    unsigned* cnt = (unsigned*)(F.ws + WS_PCNT + (size_t)(slot * 32 + pm) * 256);
    asm volatile("s_waitcnt vmcnt(0)" ::: "memory");
    __syncthreads();
    if (F.tid == 0) {
        __hip_atomic_fetch_add(cnt, 1u, __ATOMIC_RELAXED, __HIP_MEMORY_SCOPE_AGENT);
        unsigned sp = 0;
        while (__hip_atomic_load(cnt, __ATOMIC_RELAXED, __HIP_MEMORY_SCOPE_AGENT) < 8u) { __builtin_amdgcn_s_sleep(1); if (++sp > (1u << 22)) break; }
        __builtin_amdgcn_fence(__ATOMIC_ACQUIRE, "agent");
        asm volatile("s_waitcnt vmcnt(0)" ::: "memory");
    }
    __syncthreads();
    const int lp = (s - 1) / 3, kp = (s - 1) % 3, l = s / 3, k = s % 3;
#pragma unroll
    for (int q = 0; q < 3; ++q) { const int r = rbase + q;
        const int cidx = r < NCTX ? 0 : 1 + ((r - NCTX) >> 10);
        const f32x4* Gp = (const f32x4*)(COMB + (size_t)(((lp * 3 + cidx) * 3 + kp) * 3 + 0) * D);
        const f32x4* Ap = (const f32x4*)(COMB + (size_t)(((l * 3 + cidx) * 3 + k) * 3 + 1) * D);
        const f32x4* Bp = (const f32x4*)(COMB + (size_t)(((l * 3 + cidx) * 3 + k) * 3 + 2) * D);
        const u32x2* o4 = (const u32x2*)(OUTB + (size_t)r * D);
        f32x4 g[8], a[8], b[8]; u32x2 ov[8];
        const float part = lane < 32 ? __hip_atomic_load(SQ + (size_t)r * 32 + lane, __ATOMIC_RELAXED, __HIP_MEMORY_SCOPE_AGENT) : 0.f;
#pragma unroll
        for (int j = 0; j < 8; ++j) { ov[j] = o4[lane + 64 * j]; g[j] = Gp[lane + 64 * j]; }
        if (s < 6) {
#pragma unroll
            for (int j = 0; j < 8; ++j) { a[j] = Ap[lane + 64 * j]; b[j] = Bp[lane + 64 * j]; }
        }
        const float rs = rsqrtf(wave_sum(part) * (1.0f / D) + EPS);
#pragma unroll
        for (int j = 0; j < 8; ++j) {
            const f32x4 o = {__uint_as_float(ov[j].x << 16), __uint_as_float(ov[j].x & 0xffff0000u), __uint_as_float(ov[j].y << 16), __uint_as_float(ov[j].y & 0xffff0000u)};
            x[q][j] += g[j] * (o * rs); }
#pragma unroll
        for (int j = 0; j < 8; ++j) ((f32x4*)(F.out + (size_t)r * D))[lane + 64 * j] = x[q][j];
        if (s == 4 && lane < 32) WSP(float, WS_LR)[(size_t)r * 32 + lane] = 0.f;
        if (s < 6) {
            float ss = 0.f;
#pragma unroll
            for (int j = 0; j < 8; ++j) ss += (x[q][j][0] * x[q][j][0] + x[q][j][1] * x[q][j][1]) + (x[q][j][2] * x[q][j][2] + x[q][j][3] * x[q][j][3]);
            const float rr = rsqrtf(wave_sum(ss) * (1.0f / D) + EPS);
            u32x2* hb = (u32x2*)(HB + (size_t)r * D);
#pragma unroll
            for (int j = 0; j < 8; ++j) { const f32x4 h = x[q][j] * rr * a[j] + b[j]; u32x2 o; o.x = cvt_pk_bf16(h[0], h[1]); o.y = cvt_pk_bf16(h[2], h[3]); hb[lane + 64 * j] = o; }
        }
    }
}

__device__ __forceinline__ void g2_phase(Frame& F) {
    LAS float* Gs = (LAS float*)F.lds;
    LAS float* Tot = (LAS float*)(F.lds + 65536);
    LAS float* LRs = (LAS float*)(F.lds + 65536 + 2048);
    LAS bf16_t* KHs = (LAS bf16_t*)(F.lds + 65536 + 2048 + 4096);
    const int tid = F.tid, ch = tid & 255, th = __builtin_amdgcn_readfirstlane(tid >> 8);
    const bf16_t* P = WSP(bf16_t, WS_P); bf16_t* QT = WSP(bf16_t, WS_QT); bf16_t* KT = WSP(bf16_t, WS_KT); bf16_t* KHT = WSP(bf16_t, WS_KHT); float* EL = WSP(float, WS_EL);
    for (int it = blockIdx.x; it < 768; it += gridDim.x) {
        const int cgk = it >> 3, d = (it >> 2) & 1, h = it & 3;
        int b, c, row0, lat;
        if (cgk < 64) { b = cgk >> 2; c = cgk & 3; row0 = b * 256 + c * 64; lat = 0; } else { const int cl = cgk - 64; b = cl >> 4; c = cl & 15; row0 = NCTX + b * 1024 + c * 64; lat = 1; }
        const int chd = h * 256 + ch;
        for (int e = tid; e < 1024; e += 512) { const int i = e >> 4, rk = e & 15; LRs[e] = WSP(float, WS_LR)[(size_t)(row0 + i) * 32 + d * 16 + rk]; }
        float wg[16];
#pragma unroll
        for (int rk = 0; rk < 16; ++rk) wg[rk] = F.ggu[(size_t)(d * 16 + rk) * 1024 + chd];
        const float bg = F.gbg[d * 1024 + chd];
        __syncthreads();
        float run = 0.f;
        for (int ii = 0; ii < 32; ++ii) {
            const int i = d == 0 ? th * 32 + ii : th * 32 + 31 - ii;
            float xg = bg;
#pragma unroll
            for (int q4 = 0; q4 < 4; ++q4) { const f32x4 l4 = *(const LAS f32x4*)(LRs + i * 16 + q4 * 4);
                xg += l4[0] * wg[q4 * 4] + l4[1] * wg[q4 * 4 + 1] + l4[2] * wg[q4 * 4 + 2] + l4[3] * wg[q4 * 4 + 3]; }
            const float g = (fminf(xg, 0.f) - __logf(1.0f + __expf(-fabsf(xg)))) * 0.0625f;
            run += g; Gs[i * 256 + ch] = run;
        }
        Tot[th * 256 + ch] = run;
        __syncthreads();
        const float tot0 = Tot[ch], tot1 = Tot[256 + ch], total = tot0 + tot1;
        const float fix = (d == 0) ? (th == 1 ? tot0 : 0.f) : (th == 0 ? tot1 : 0.f);
        const int p = ch >> 1;
        const float inv = exp2f(-(float)(p & 63) * (13.287712379549449f / 64.0f));
        const int qcol = (d ? 2048 : 0) + chd, kcol = (d ? 3072 : 1024) + chd;
        const float elc = __expf(total);
        bf16_t qraw[32], kraw[32];
#pragma unroll
        for (int ii = 0; ii < 32; ++ii) { const size_t row = (size_t)(row0 + th * 32 + ii); qraw[ii] = P[row * PLD + qcol]; kraw[ii] = P[row * PLD + kcol]; }
#pragma unroll
        for (int ii = 0; ii < 32; ++ii) {
            const int i = th * 32 + ii; const size_t row = (size_t)(row0 + i);
            const float bb = Gs[i * 256 + ch] + fix;
            float qv = bf2f(qraw[ii]), kv = bf2f(kraw[ii]);
            if (lat) {
                const float ang = (float)(p < 64 ? c : i) * inv; const float sn = __sinf(ang), cs = __cosf(ang);
                const float qo = __shfl_xor(qv, 1), ko = __shfl_xor(kv, 1);
                if (ch & 1) { qv = qo * sn + qv * cs; kv = ko * sn + kv * cs; } else { qv = qv * cs - qo * sn; kv = kv * cs - ko * sn; }
            }
            const float qt = qv * 0.0625f * __expf(bb), kt = kv * __expf(-bb), kh = kt * elc;
            QT[((size_t)d * MROWS + row) * 1024 + chd] = (bf16_t)(cvt_pk_bf16(qt, 0.f) & 0xffffu);
            KT[((size_t)d * MROWS + row) * 1024 + chd] = (bf16_t)(cvt_pk_bf16(kt, 0.f) & 0xffffu);
            KHs[ch * 72 + i] = (bf16_t)(cvt_pk_bf16(kh, 0.f) & 0xffffu);
        }
        if (th == 0) EL[(size_t)(d * 96 + cgk) * 1024 + chd] = elc;
        __syncthreads();
        { const int rch = tid >> 1, hf = tid & 1;
          bf16_t* dst = (lat ? KHT + (size_t)2 * 16 * 1024 * 256 + ((size_t)((d * 2 + b) * 1024 + h * 256 + rch)) * 1024 : KHT + ((size_t)((d * 16 + b) * 1024 + h * 256 + rch)) * 256) + c * 64 + hf * 32;
          const LAS u32x4* src = (const LAS u32x4*)(KHs + rch * 72 + hf * 32);
#pragma unroll
          for (int j = 0; j < 4; ++j) ((u32x4*)dst)[j] = src[j]; }
        __syncthreads();
    }
}

constexpr int SC_QS = 0, SC_KS = 33792, SC_STS = 67584, SC_KHS = 101376, SC_VS = 138240, SC_PS = 147456, SC_ELS = 156672;
__device__ __forceinline__ int scan_item(int c, int G, int k) {
    if (G == 256) { const int x = c & 7, y = c >> 3, vs = y & 7;
        if (y < 16) { if (k == 0) return ((x + 8 * (y >> 3)) << 3) | vs; if (k < 3) return 128 + (((x + 8 * ((y >> 3) * 2 + (k - 1))) << 3) | vs); return -1; }
        return k < 6 ? 128 + (((32 + x + 8 * (((y - 16) >> 3) * 6 + k)) << 3) | vs) : -1; }
    const int id = k * G + c; return id < 1152 ? id : -1;
}
__device__ __forceinline__ void scan_phase(Frame& F) {
    const int tid = F.tid, lane = F.lane, w = F.wave, fr = lane & 15, fq = lane >> 4;
    LAS unsigned char* lds = F.lds;
    const bf16_t* QT = WSP(bf16_t, WS_QT); const bf16_t* KT = WSP(bf16_t, WS_KT); const bf16_t* KHT = WSP(bf16_t, WS_KHT); const bf16_t* VT = WSP(bf16_t, WS_VT);
    const float* EL = WSP(float, WS_EL); bf16_t* O = WSP(bf16_t, WS_O);
    for (int kk_ = 0;; ++kk_) {
        const int id = scan_item(blockIdx.x, gridDim.x, kk_); if (id < 0) break;
        const int lat = id < 128, ii = lat ? id : id - 128, vs = ii & 7, d = (ii >> 3) & 1, h = (ii >> 4) & 3, b = ii >> 6;
        const int T = lat ? 1024 : 256, nch = T >> 6, rowb = lat ? NCTX + b * 1024 : b * 256;
        const bf16_t* Qp = QT + ((size_t)d * MROWS + rowb) * 1024 + h * 256;
        const bf16_t* Kp = KT + ((size_t)d * MROWS + rowb) * 1024 + h * 256;
        const bf16_t* KHp = lat ? KHT + (size_t)2 * 16 * 1024 * 256 + ((size_t)((d * 2 + b) * 1024 + h * 256)) * 1024 : KHT + ((size_t)((d * 16 + b) * 1024 + h * 256)) * 256;
        const bf16_t* Vp = lat ? VT + (size_t)16 * 2048 * 256 + ((size_t)(b * 2048 + h * 512 + vs * 64)) * 1024 : VT + ((size_t)(b * 2048 + h * 512 + vs * 64)) * 256;
        const float* ELp = EL + (size_t)(d * 96 + (lat ? 64 + b * 16 : b * 4)) * 1024 + h * 256;
        bf16_t* Op = O + ((size_t)d * MROWS + rowb) * D + h * 512 + vs * 64;
        f32x4 acc[2][4];
        float zz = 0.f; asm volatile("" : "+v"(zz));
        if (lat) { const float* S0 = F.state + ((size_t)((b * 2 + d) * 4 + h)) * 256 * 512 + vs * 64;
            int sb = (w * 32 + 4 * fq) * 512 + fr; asm volatile("" : "+v"(sb));
#pragma unroll
            for (int ct = 0; ct < 2; ++ct)
#pragma unroll
                for (int vt = 0; vt < 4; ++vt)
#pragma unroll
                    for (int jj = 0; jj < 4; ++jj) acc[ct][vt][jj] = S0[sb + (ct * 16 + jj) * 512 + vt * 16]; }
        else {
#pragma unroll
            for (int ct = 0; ct < 2; ++ct)
#pragma unroll
                for (int vt = 0; vt < 4; ++vt) acc[ct][vt] = (f32x4){zz, zz, zz, zz}; }
#define SC_WRITE_STS() do { _Pragma("unroll") for (int ct = 0; ct < 2; ++ct) _Pragma("unroll") for (int vt = 0; vt < 4; ++vt) { u32x2 o_; o_.x = cvt_pk_bf16(acc[ct][vt][0], acc[ct][vt][1]); o_.y = cvt_pk_bf16(acc[ct][vt][2], acc[ct][vt][3]); \
            *(LAS u32x2*)(lds + SC_STS + (vt * 16 + fr) * 528 + (w * 32 + ct * 16 + 4 * fq) * 2) = o_; } } while (0)
        SC_WRITE_STS();
        u32x4 pq[4], pk[4], ph[4], pv; f32x4 pe = {zz, zz, zz, zz};
#define SC_LOAD_QK(cc) do { const int c_ = (cc); \
            _Pragma("unroll") for (int q = 0; q < 4; ++q) { const int e = tid + 512 * q, row = e >> 5, ck = e & 31; \
                pq[q] = *(const u32x4*)(Qp + (size_t)(c_ * 64 + row) * 1024 + ck * 8); pk[q] = *(const u32x4*)(Kp + (size_t)(c_ * 64 + row) * 1024 + ck * 8); } } while (0)
#define SC_LOAD_KVE(cc) do { const int c_ = (cc); \
            _Pragma("unroll") for (int q = 0; q < 4; ++q) { const int e = tid + 512 * q, row = e >> 3, ck = e & 7; ph[q] = *(const u32x4*)(KHp + (size_t)row * T + c_ * 64 + ck * 8); } \
            { const int row = tid >> 3, ck = tid & 7; pv = *(const u32x4*)(Vp + (size_t)row * T + c_ * 64 + ck * 8); } \
            if (tid < 64) pe = *(const f32x4*)(ELp + (size_t)c_ * 1024 + tid * 4); } while (0)
#define SC_STORE_QK() do { \
            _Pragma("unroll") for (int q = 0; q < 4; ++q) { const int e = tid + 512 * q, row = e >> 5, ck = e & 31; \
                *(LAS u32x4*)(lds + SC_QS + row * 528 + ck * 16) = pq[q]; *(LAS u32x4*)(lds + SC_KS + row * 528 + ck * 16) = pk[q]; } } while (0)
#define SC_STORE_KVE() do { \
            _Pragma("unroll") for (int q = 0; q < 4; ++q) { const int e = tid + 512 * q, row = e >> 3, ck = e & 7; *(LAS u32x4*)(lds + SC_KHS + row * 144 + ck * 16) = ph[q]; } \
            { const int row = tid >> 3, ck = tid & 7; *(LAS u32x4*)(lds + SC_VS + row * 144 + ck * 16) = pv; } \
            if (tid < 64) *(LAS f32x4*)(lds + SC_ELS + tid * 16) = pe; } while (0)
#define SC_CH(s_) (d == 0 ? (s_) : nch - 1 - (s_))
        SC_LOAD_QK(SC_CH(0)); SC_LOAD_KVE(SC_CH(0));
        SC_STORE_QK(); SC_STORE_KVE();
        __syncthreads();
        if (nch > 1) { SC_LOAD_QK(SC_CH(1)); SC_LOAD_KVE(SC_CH(1)); }
        const int itile = w >> 1, t2 = (w & 1) * 2;
        for (int s = 0; s < nch; ++s) {
            const int c = SC_CH(s);
#define SC_LD8(dst, off) do { _Pragma("unroll") for (int kk = 0; kk < 8; ++kk) dst[kk] = *(const LAS bf16x8*)(lds + (off) + kk * 64); } while (0)
#define SC_MM8(accv, af, bf_) do { f32x4 acc2_ = {zz, zz, zz, zz}; _Pragma("unroll") for (int kk = 0; kk < 4; ++kk) { accv = __builtin_amdgcn_mfma_f32_16x16x32_bf16(af[kk], bf_[kk], accv, 0, 0, 0); \
        acc2_ = __builtin_amdgcn_mfma_f32_16x16x32_bf16(af[kk + 4], bf_[kk + 4], acc2_, 0, 0, 0); } accv += acc2_; } while (0)
#define SC_KEEP8(x) asm volatile("" :: "v"(x[0]), "v"(x[1]), "v"(x[2]), "v"(x[3]), "v"(x[4]), "v"(x[5]), "v"(x[6]), "v"(x[7]))
            bf16x8 qf[8], fa[8];
            const int qoff = SC_QS + (itile * 16 + fr) * 528 + fq * 16;
            const int jt0 = t2, jt1 = t2 + 1;
            const bool live0 = d == 0 ? (jt0 <= itile) : (jt0 >= itile), live1 = d == 0 ? (jt1 <= itile) : (jt1 >= itile);
            f32x4 sc0 = {zz, zz, zz, zz}, sc1 = {zz, zz, zz, zz};
            f32x4 oa[2]; oa[0] = (f32x4){zz, zz, zz, zz}; oa[1] = (f32x4){zz, zz, zz, zz};
            SC_LD8(qf, qoff);
            if (live0) { SC_LD8(fa, SC_KS + (jt0 * 16 + fr) * 528 + fq * 16); __builtin_amdgcn_sched_barrier(0); SC_MM8(sc0, fa, qf); __builtin_amdgcn_sched_barrier(0); }
            if (live1) { SC_LD8(fa, SC_KS + (jt1 * 16 + fr) * 528 + fq * 16); __builtin_amdgcn_sched_barrier(0); SC_MM8(sc1, fa, qf); __builtin_amdgcn_sched_barrier(0); }
            SC_LD8(fa, SC_STS + ((t2 + 0) * 16 + fr) * 528 + fq * 16); __builtin_amdgcn_sched_barrier(0); SC_MM8(oa[0], fa, qf); __builtin_amdgcn_sched_barrier(0);
            SC_LD8(fa, SC_STS + ((t2 + 1) * 16 + fr) * 528 + fq * 16); __builtin_amdgcn_sched_barrier(0); SC_MM8(oa[1], fa, qf); __builtin_amdgcn_sched_barrier(0);
            { const int iabs = itile * 16 + fr;
#pragma unroll
              for (int jj = 0; jj < 4; ++jj) { const int j0 = jt0 * 16 + 4 * fq + jj, j1 = jt1 * 16 + 4 * fq + jj;
                  const bool ok0 = live0 && (d == 0 ? (j0 <= iabs) : (j0 >= iabs)), ok1 = live1 && (d == 0 ? (j1 <= iabs) : (j1 >= iabs));
                  sc0[jj] = ok0 ? sc0[jj] : 0.f; sc1[jj] = ok1 ? sc1[jj] : 0.f; }
              u32x2 o0, o1; o0.x = cvt_pk_bf16(sc0[0], sc0[1]); o0.y = cvt_pk_bf16(sc0[2], sc0[3]); o1.x = cvt_pk_bf16(sc1[0], sc1[1]); o1.y = cvt_pk_bf16(sc1[2], sc1[3]);
              *(LAS u32x2*)(lds + SC_PS + (itile * 16 + fr) * 144 + (jt0 * 16 + 4 * fq) * 2) = o0;
              *(LAS u32x2*)(lds + SC_PS + (itile * 16 + fr) * 144 + (jt1 * 16 + 4 * fq) * 2) = o1; }
            __syncthreads();
            if (s + 1 < nch) { SC_STORE_QK(); if (s + 2 < nch) SC_LOAD_QK(SC_CH(s + 2)); }
            bf16x8 pf[2], va[2][2];
#pragma unroll
            for (int kk = 0; kk < 2; ++kk) pf[kk] = *(const LAS bf16x8*)(lds + SC_PS + (itile * 16 + fr) * 144 + kk * 64 + fq * 16);
#pragma unroll
            for (int v2 = 0; v2 < 2; ++v2)
#pragma unroll
                for (int kk = 0; kk < 2; ++kk) va[v2][kk] = *(const LAS bf16x8*)(lds + SC_VS + ((t2 + v2) * 16 + fr) * 144 + kk * 64 + fq * 16);
            __builtin_amdgcn_sched_barrier(0);
#pragma unroll
            for (int v2 = 0; v2 < 2; ++v2) { const int vt = t2 + v2;
#pragma unroll
                for (int kk = 0; kk < 2; ++kk) oa[v2] = __builtin_amdgcn_mfma_f32_16x16x32_bf16(va[v2][kk], pf[kk], oa[v2], 0, 0, 0);
                { u32x2 ob_; ob_.x = cvt_pk_bf16(oa[v2][0], oa[v2][1]); ob_.y = cvt_pk_bf16(oa[v2][2], oa[v2][3]); *(u32x2*)(Op + (size_t)(c * 64 + itile * 16 + fr) * D + vt * 16 + 4 * fq) = ob_; } }
            __builtin_amdgcn_sched_barrier(0);
            bf16x8 kf[2][2], vb[4][2]; f32x4 el4[2];
#pragma unroll
            for (int ct = 0; ct < 2; ++ct) { el4[ct] = *(const LAS f32x4*)(lds + SC_ELS + (w * 32 + ct * 16 + 4 * fq) * 4);
#pragma unroll
                for (int kk = 0; kk < 2; ++kk) kf[ct][kk] = *(const LAS bf16x8*)(lds + SC_KHS + (w * 32 + ct * 16 + fr) * 144 + kk * 64 + fq * 16); }
#pragma unroll
            for (int vt = 0; vt < 4; ++vt)
#pragma unroll
                for (int kk = 0; kk < 2; ++kk) vb[vt][kk] = *(const LAS bf16x8*)(lds + SC_VS + (vt * 16 + fr) * 144 + kk * 64 + fq * 16);
            __builtin_amdgcn_sched_barrier(0);
#pragma unroll
            for (int ct = 0; ct < 2; ++ct)
#pragma unroll
                for (int vt = 0; vt < 4; ++vt) { acc[ct][vt] = acc[ct][vt] * el4[ct];
#pragma unroll
                    for (int kk = 0; kk < 2; ++kk) acc[ct][vt] = __builtin_amdgcn_mfma_f32_16x16x32_bf16(kf[ct][kk], vb[vt][kk], acc[ct][vt], 0, 0, 0); }
#undef SC_LD8
#undef SC_MM8
#undef SC_KEEP8
            SC_WRITE_STS();
            __syncthreads();
            if (s + 1 < nch) { SC_STORE_KVE(); if (s + 2 < nch) SC_LOAD_KVE(SC_CH(s + 2)); }
        }
        if (!lat) { float* So = F.out + (size_t)MROWS * D + ((size_t)((b * 2 + d) * 4 + h)) * 256 * 512 + vs * 64;
            int sb = (w * 32 + 4 * fq) * 512 + fr; asm volatile("" : "+v"(sb));
#pragma unroll
            for (int ct = 0; ct < 2; ++ct)
#pragma unroll
                for (int vt = 0; vt < 4; ++vt)
#pragma unroll
                    for (int jj = 0; jj < 4; ++jj) So[sb + (ct * 16 + jj) * 512 + vt * 16] = acc[ct][vt][jj]; }
#undef SC_WRITE_STS
#undef SC_LOAD_QK
#undef SC_LOAD_KVE
#undef SC_STORE_QK
#undef SC_STORE_KVE
#undef SC_CH
    }
}

__device__ __forceinline__ void g4_phase(Frame& F) {
    const int gw = blockIdx.x * 8 + F.wave, NGW = gridDim.x * 8, lane = F.lane;
    const bf16_t* O = WSP(bf16_t, WS_O); const bf16_t* P = WSP(bf16_t, WS_P); bf16_t* ON = WSP(bf16_t, WS_ON);
    for (int r = gw; r < MROWS; r += NGW) {
        const u32x2* o0 = (const u32x2*)(O + (size_t)r * D); const u32x2* o1 = (const u32x2*)(O + ((size_t)MROWS + r) * D);
        const u32x2* rg = (const u32x2*)(P + (size_t)r * PLD + 4096);
        f32x4 o[8]; u32x2 oa_[8], ob_[8], rv_[8]; const f32x4 gn0 = ((const f32x4*)F.gnorm)[lane], gn1 = ((const f32x4*)F.gnorm)[lane + 64];
#pragma unroll
        for (int j = 0; j < 8; ++j) { oa_[j] = o0[lane + 64 * j]; ob_[j] = o1[lane + 64 * j]; rv_[j] = rg[lane + 64 * j]; }
#pragma unroll
        for (int j = 0; j < 8; ++j) { o[j][0] = __uint_as_float(oa_[j].x << 16) + __uint_as_float(ob_[j].x << 16); o[j][1] = __uint_as_float(oa_[j].x & 0xffff0000u) + __uint_as_float(ob_[j].x & 0xffff0000u);
            o[j][2] = __uint_as_float(oa_[j].y << 16) + __uint_as_float(ob_[j].y << 16); o[j][3] = __uint_as_float(oa_[j].y & 0xffff0000u) + __uint_as_float(ob_[j].y & 0xffff0000u); }
        float rr[4];
#pragma unroll
        for (int hh = 0; hh < 4; ++hh) { float s = 0.f;
#pragma unroll
            for (int j = 2 * hh; j < 2 * hh + 2; ++j) s += (o[j][0] * o[j][0] + o[j][1] * o[j][1]) + (o[j][2] * o[j][2] + o[j][3] * o[j][3]);
            rr[hh] = rsqrtf(wave_sum(s) * (1.0f / 512.0f) + EPS); }
        u32x2* on = (u32x2*)(ON + (size_t)r * D);
#pragma unroll
        for (int j = 0; j < 8; ++j) { const f32x4 gn = (j & 1) ? gn1 : gn0; const u32x2 rv = rv_[j];
            const float r0 = __uint_as_float(rv.x << 16), r1 = __uint_as_float(rv.x & 0xffff0000u), r2 = __uint_as_float(rv.y << 16), r3 = __uint_as_float(rv.y & 0xffff0000u);
            const f32x4 v = o[j] * rr[j >> 1] * gn;
            u32x2 w_; w_.x = cvt_pk_bf16(v[0] * silu_f(r0), v[1] * silu_f(r1)); w_.y = cvt_pk_bf16(v[2] * silu_f(r2), v[3] * silu_f(r3)); on[lane + 64 * j] = w_; }
    }
}

enum { K_PRO = 0, K_ELEM, K_SWI, K_F32, K_BF, K_G2, K_SCAN, K_G4 };

template <int kind, int arg>
__device__ __forceinline__ void stage_dispatch(Frame& F, const int G, const int c) {
        if (kind == K_PRO) prologue(F);
        else if (kind == K_ELEM) elem_phase(F, arg);
        else if (kind == K_SWI) {
            pg8::Sched S{}; S.A = (const char*)WSP(bf16_t, WS_HB); S.B = (const char*)(WSP(bf16_t, WS_W1) + (size_t)arg * W1_ELEMS); S.A2 = S.A; S.B2 = S.B; S.sAz = 0; S.sBz = 0;
            S.lda = D; S.ldb = D; S.nM = 24; S.nN = 44; S.nZ = 1; S.nM2 = 0; S.nN2 = 1; S.nwg = 24 * 44; S.G = G; S.c = c; S.bm = 256;
            pg8::EpiSwiGLU<4> E{WSP(bf16_t, WS_HID), 0, 0};
            if (G == 256) {
                S.nwg = 1024;
                pg8::gemm_phase<pg8::EpiSwiGLU<4>, 4, GP_ALIGN, GP_SP2>(F.lds, F.tid, S, D / 64, E);
                pg8::Sched S2 = S; S2.A = S.A + (size_t)5120 * D * 2; S2.B = S.B + (size_t)36 * 256 * D * 2; S2.A2 = S2.A; S2.B2 = S2.B; S2.nM = 8; S2.nN = 8; S2.nwg = 64; S2.bm = 128;
                pg8::EpiSwiGLU<2> E2{WSP(bf16_t, WS_HID), 5120, 36};
                pg8::gemm_phase<pg8::EpiSwiGLU<2>, 2, false, GP_SP2>(F.lds, F.tid, S2, D / 64, E2);
            } else
            pg8::gemm_phase<pg8::EpiSwiGLU<4>, 4, GP_ALIGN, GP_SP2>(F.lds, F.tid, S, D / 64, E);
            if (arg < 3) { const int first = (G == 256) ? 64 : S.nwg % G; if (c >= first) { convert_ffn(F, arg + 1, c - first, G - first); if (arg == 1) convert_misc<2>(F, c - first, G - first); } }
        } else if (kind == K_F32) {
            pg8::Sched S{}; int nt;
            if (arg < 4) { S.A = (const char*)WSP(bf16_t, WS_HID); S.B = (const char*)(WSP(bf16_t, WS_W2) + (size_t)arg * W2_ELEMS); S.lda = FF; S.ldb = FF; nt = FF / 64; }
            else if (arg == 4) { S.A = (const char*)WSP(bf16_t, WS_FB); S.B = (const char*)WSP(bf16_t, WS_FW); S.lda = D; S.ldb = D; nt = D / 64; }
            else { S.A = (const char*)WSP(bf16_t, WS_ON); S.B = (const char*)WSP(bf16_t, WS_WO); S.lda = D; S.ldb = D; nt = D / 64; }
            S.A2 = S.A; S.B2 = S.B; S.sAz = 0; S.sBz = 0; S.nM = 32; S.nN = 8; S.nZ = 1; S.nM2 = 0; S.nN2 = 1; S.nwg = 256; S.G = G; S.c = c; S.bm = 192;
            pg8::EpiF32Sq E{WSP(bf16_t, WS_OUTF), WSP(float, WS_SQ)};
            pg8::gemm_phase<pg8::EpiF32Sq, 3, false, false>(F.lds, F.tid, S, nt, E);
        } else if (kind == K_BF) {
            pg8::Sched S{}; pg8::EpiBf16 E{}; int nt; E.mode = arg; E.wsb = F.ws; S.G = G; S.c = c; S.nM2 = 0; S.nN2 = 1; S.bm = 256;
            if (arg == pg8::M_GIN) {
                S.A = (const char*)WSP(bf16_t, WS_HB); S.B = (const char*)WSP(bf16_t, WS_WA); S.A2 = (const char*)WSP(bf16_t, WS_WV); S.B2 = (const char*)WSP(bf16_t, WS_HB);
                S.sAz = 0; S.sBz = 0; S.lda = D; S.ldb = D; S.nM = 24; S.nN = 24; S.nZ = 1; S.nM2 = 8; S.nN2 = 24; S.nwg = 576 + 192; nt = D / 64;
                E.d0 = WSP(bf16_t, WS_P); E.d1 = WSP(bf16_t, WS_VT);
            } else if (arg == pg8::M_FA) {
                S.A = (const char*)WSP(bf16_t, WS_FCT); S.B = (const char*)WSP(bf16_t, WS_HB); S.A2 = S.A; S.B2 = S.B; S.sAz = 0; S.sBz = 512 * 2;
                S.lda = 512; S.ldb = D; S.nM = 4; S.nN = 24; S.nZ = 4; S.nwg = 384; nt = 8;
                E.d0 = WSP(bf16_t, WS_YT); E.d1 = WSP(bf16_t, WS_YT) + (size_t)16 * 2048 * 512;
            } else if (arg == pg8::M_FBC) {
                S.A = (const char*)WSP(bf16_t, WS_CTC); S.B = (const char*)WSP(bf16_t, WS_YT); S.A2 = S.A; S.B2 = S.B; S.sAz = 0; S.sBz = (long)2048 * 512 * 2;
                S.lda = 512; S.ldb = 512; S.nM = 1; S.nN = 8; S.nZ = 16; S.nwg = 128; nt = 8;
                E.d0 = WSP(bf16_t, WS_FB); E.d1 = E.d0;
            } else {
                S.A = (const char*)WSP(bf16_t, WS_CTL); S.B = (const char*)(WSP(bf16_t, WS_YT) + (size_t)16 * 2048 * 512); S.A2 = S.A; S.B2 = S.B; S.sAz = 0; S.sBz = (long)2048 * 2048 * 2;
                S.lda = D; S.ldb = D; S.nM = 4; S.nN = 8; S.nZ = 2; S.nwg = 64; nt = 32; S.c = (G == 256) ? ((c + 128) & 255) : c;
                E.d0 = WSP(bf16_t, WS_FB); E.d1 = E.d0;
            }
            pg8::gemm_phase<pg8::EpiBf16, 4, GP_ALIGN, GP_SP2>(F.lds, F.tid, S, nt, E);
            if (arg == pg8::M_FA) { const int first = S.nwg % G; if (first > 0 && c >= first) convert_misc<1>(F, c - first, G - first); else if (first == 0) convert_misc<1>(F, c, G); }
            if (arg == pg8::M_GIN) {
                pg8::Sched S2{}; S2.A = (const char*)WSP(bf16_t, WS_HB); S2.B = (const char*)(WSP(bf16_t, WS_WA) + (size_t)6144 * D); S2.A2 = S2.A; S2.B2 = S2.B; S2.sAz = 512; S2.sBz = 512;
                S2.lda = D; S2.ldb = D; S2.nM = 24; S2.nN = 1; S2.nZ = 8; S2.nM2 = 0; S2.nN2 = 1; S2.nwg = 192; S2.G = G; S2.c = c; S2.bm = 256;
                pg8::EpiLrAtomic E2{WSP(float, WS_LR)};
                pg8::gemm_phase<pg8::EpiLrAtomic, 4, false, GP_SP2>(F.lds, F.tid, S2, 4, E2);
            }
            if (arg == pg8::M_FBL) { if (S.c >= S.nwg) { const int np = G - S.nwg; convert_misc<4>(F, S.c - S.nwg, np > 0 ? np : 1); } else if (G <= S.nwg) convert_misc<4>(F, c, G); }
        } else if (kind == K_G2) g2_phase(F);
        else if (kind == K_SCAN) scan_phase(F);
        else g4_phase(F);
}

#define LDP(i) ((const float*)(w_ + ldoff(tab, (i))))
#define STAGE_SETUP() \
        { int t_ = threadIdx.x; asm volatile("" : "+v"(t_)); F.tid = t_; F.lane = t_ & 63; F.wave = __builtin_amdgcn_readfirstlane(t_ >> 6); \
          size_t z_ = 0; asm volatile("" : "+s"(z_)); unsigned char* w_ = args.ws + z_; F.ws = w_; \
          const long long* tab = (const long long*)(w_ + WS_PTRTAB); \
          F.xp = LDP(0); F.xs = LDP(1); F.state = LDP(2); F.cnd = LDP(3); F.cctx = LDP(4); F.adaw = LDP(5); F.adab = LDP(6); F.npre = LDP(7); F.npost = LDP(8); \
          F.wgu = LDP(9); F.wdn = LDP(10); F.fw = LDP(11); F.gin = LDP(12); F.ggu = LDP(13); F.gbg = LDP(14); F.gnorm = LDP(15); F.gout = LDP(16); F.out = (float*)LDP(17); \
        }
__global__ void __launch_bounds__(512, 2) fwd_megakernel(Args args) {
    extern __shared__ __attribute__((aligned(16))) unsigned char lds_raw[];
    cg::grid_group grid = cg::this_grid();
    Frame F;
    F.lds = (LAS unsigned char*)lds_raw;
    const int G = gridDim.x, c = blockIdx.x;
    if (threadIdx.x < 16) ((LAS unsigned*)(F.lds + LDS_BARST))[threadIdx.x] = 0u;
    if (threadIdx.x == 0) { long long* tab = (long long*)(args.ws + WS_PTRTAB); const char* wb = (const char*)args.ws;
#pragma unroll
        for (int i = 0; i < 17; ++i) tab[i] = (long long)((const char*)args.in[i] - wb);
        tab[17] = (long long)((const char*)args.out - wb);
        __threadfence(); }
    __syncthreads();
    const XcdBarrier xbar = xcd_barrier_post((unsigned*)args.ws, (volatile LAS unsigned*)(F.lds + LDS_BARST));
#define RUN_STAGE(KIND, ARG, SYNC) do { constexpr int kind = (KIND), arg = (ARG); \
        STAGE_SETUP(); \
        stage_dispatch<kind, arg>(F, G, c); \
        if (SYNC) { if ((SYNC) == 2 && args.ws == nullptr) grid.sync(); xcd_barrier(xbar); } } while (0)
#define RUN_F32E(ARG, S, SLOT) do { \
        STAGE_SETUP(); \
        stage_dispatch<K_F32, (ARG)>(F, G, c); \
        if (G == 256) { pg8::Sched S_{}; S_.nM = 32; S_.nN = 8; S_.nZ = 1; S_.nM2 = 0; S_.nN2 = 1; S_.nwg = 256; S_.G = G; S_.c = c; S_.bm = 192; S_.lda = D; S_.ldb = D; S_.A = (const char*)F.ws; S_.B = S_.A; S_.A2 = S_.A; S_.B2 = S_.A; \
            pg8::Unit u_; (void)S_.next(0, u_); fused_elem(F, (S), (SLOT), u_.pm, u_.pn); } \
        else { xcd_barrier(xbar); STAGE_SETUP(); elem_phase(F, (S)); } \
        if ((S) < 6) xcd_barrier(xbar); } while (0)
    RUN_STAGE(K_PRO, 0, 2);
    RUN_STAGE(K_ELEM, 0, 1); RUN_STAGE(K_SWI, 0, 1); RUN_F32E(0, 1, 0);
    RUN_STAGE(K_BF, pg8::M_FA, 1); RUN_STAGE(K_BF, pg8::M_FBC, 0); RUN_STAGE(K_BF, pg8::M_FBL, 1); RUN_F32E(4, 2, 1);
    RUN_STAGE(K_SWI, 1, 1); RUN_F32E(1, 3, 2);
    RUN_STAGE(K_SWI, 2, 1); RUN_F32E(2, 4, 3);
    RUN_STAGE(K_BF, pg8::M_GIN, 1); RUN_STAGE(K_G2, 0, 1); RUN_STAGE(K_SCAN, 0, 1); RUN_STAGE(K_G4, 0, 1); RUN_F32E(5, 5, 4);
    RUN_STAGE(K_SWI, 3, 1); RUN_F32E(3, 6, 5);
#undef RUN_F32E
#undef RUN_STAGE
}

extern "C" void kernel_launch(void* const* d_in, const int* in_sizes, int n_in, void* d_out, int out_size, void* d_ws, size_t ws_size, hipStream_t stream) {
    static int grid_blocks = 0;
    if (grid_blocks == 0) {
        if (n_in != 17 || ws_size < WS_END) { fprintf(stderr, "kernel_launch: unexpected inputs (n_in %d, ws %zu)\n", n_in, ws_size); grid_blocks = -1; return; }
        int dev = 0, cus = 0, per_cu = 0;
        (void)hipGetDevice(&dev);
        (void)hipDeviceGetAttribute(&cus, hipDeviceAttributeMultiprocessorCount, dev);
        if (hipFuncSetAttribute((const void*)fwd_megakernel, hipFuncAttributeMaxDynamicSharedMemorySize, LDS_BYTES) != hipSuccess) { fprintf(stderr, "kernel_launch: hipFuncSetAttribute failed\n"); grid_blocks = -1; return; }
        if (hipOccupancyMaxActiveBlocksPerMultiprocessor(&per_cu, (const void*)fwd_megakernel, 512, LDS_BYTES) != hipSuccess || per_cu < 1) { fprintf(stderr, "kernel_launch: occupancy query failed (%d)\n", per_cu); (void)hipGetLastError(); per_cu = 1; }
        grid_blocks = cus * per_cu;
    }
    if (grid_blocks < 0) return;
    if (hipMemsetAsync(d_ws, 0, 131072, stream) != hipSuccess) { fprintf(stderr, "kernel_launch: memset of barrier words failed\n"); return; }
    Args a{};
    for (int i = 0; i < 17; ++i) a.in[i] = (const float*)d_in[i];
    a.out = (float*)d_out; a.ws = (unsigned char*)d_ws;
    void* kargs[] = {&a};
    hipError_t e = hipLaunchCooperativeKernel((const void*)fwd_megakernel, dim3(grid_blocks), dim3(512), kargs, LDS_BYTES, stream);
    if (e != hipSuccess) fprintf(stderr, "cooperative launch failed: %s (grid %d)\n", hipGetErrorString(e), grid_blocks);
}
```
